# Optimizing an MI355X kernel written in HIP

```python
import functools
import jax, jax.numpy as jnp
from jax import lax
import numpy as np

D_MODEL = 1024
BATCH = 8
SEQ = 8192
DEPTH = 1
DEC_BATCH = 32
DEC_SEQ = 16
PAST_LEN = 2048

CHUNK = 64
LEFT_CHUNKS = 8
ATT_WINDOW = LEFT_CHUNKS * CHUNK
BAND = (LEFT_CHUNKS + 1) * CHUNK
N_HEADS = 8
HEAD_DIM = 64
D_ATT = N_HEADS * HEAD_DIM
D_CONV = D_MODEL // 2
CONV_WIDTH = 3
MAX_REL = 128
D_FF = 2816
D_PLE = 256
N_NORMS = 7
EPS = 1e-6
NEG_INF = -1e30
SPLITS = (D_ATT, 2 * D_ATT, 3 * D_ATT, 3 * D_ATT + D_CONV, 3 * D_ATT + 2 * D_CONV,
          3 * D_ATT + 3 * D_CONV, 3 * D_ATT + 3 * D_CONV + D_MODEL)
D_IN = 3 * D_ATT + 3 * D_CONV + 2 * D_MODEL

kernel_name = "streaming_hybrid_chunkattn_shortconv_step"


def rmsnorm(x, g):
    xf = x.astype(jnp.float32)
    y = xf * lax.rsqrt(jnp.mean(xf * xf, axis=-1, keepdims=True) + EPS) * g.astype(jnp.float32)
    return y.astype(x.dtype)


def swiglu(x, w_gate, w_up, w_down):
    return (jax.nn.silu(x @ w_gate) * (x @ w_up)) @ w_down


def rel_bias_lookup(table, d):
    idx = jnp.clip(d, -MAX_REL, MAX_REL) + MAX_REL
    return table[:, idx].astype(jnp.float32)


def chunk_band_attention(q, k, v, table):
    S = q.shape[1]
    nc = S // CHUNK
    n = jnp.arange(BAND)
    i = jnp.arange(CHUNK)
    bias = rel_bias_lookup(table, i[:, None] + ATT_WINDOW - n[None, :])
    c = jnp.arange(nc)
    valid = (c[:, None] * CHUNK - ATT_WINDOW + n[None, :]) >= 0
    scale = HEAD_DIM ** -0.5
    pad = ((ATT_WINDOW, 0), (0, 0), (0, 0))

    def one_seq(args):
        qs, ks, vs = args
        kp = jnp.pad(ks, pad).reshape(nc + LEFT_CHUNKS, CHUNK, N_HEADS, HEAD_DIM)
        vp = jnp.pad(vs, pad).reshape(nc + LEFT_CHUNKS, CHUNK, N_HEADS, HEAD_DIM)
        kb = jnp.concatenate([kp[j:j + nc] for j in range(LEFT_CHUNKS + 1)], axis=1)
        vb = jnp.concatenate([vp[j:j + nc] for j in range(LEFT_CHUNKS + 1)], axis=1)
        qc = qs.reshape(nc, CHUNK, N_HEADS, HEAD_DIM)
        s = jnp.einsum('cqhd,ckhd->chqk', qc, kb).astype(jnp.float32) * scale + bias[None]
        s = jnp.where(valid[:, None, None, :], s, NEG_INF)
        p = jax.nn.softmax(s, axis=-1).astype(vs.dtype)
        o = jnp.einsum('chqk,ckhd->cqhd', p, vb)
        return o.reshape(S, D_ATT)

    return lax.map(one_seq, (q, k, v))


def cached_band_attention(q, k, v, k_cache, v_cache, table):
    Lc = k_cache.shape[1]
    T = q.shape[1]
    kk = jnp.concatenate([k_cache.astype(k.dtype), k], axis=1)
    vv = jnp.concatenate([v_cache.astype(v.dtype), v], axis=1)
    d = (Lc + jnp.arange(T))[:, None] - jnp.arange(Lc + T)[None, :]
    bias = rel_bias_lookup(table, d)
    s = jnp.einsum('bqhd,bkhd->bhqk', q, kk).astype(jnp.float32) * (HEAD_DIM ** -0.5) + bias[None]
    p = jax.nn.softmax(s, axis=-1).astype(vv.dtype)
    o = jnp.einsum('bhqk,bkhd->bqhd', p, vv)
    return o.reshape(q.shape[0], T, D_ATT)


def short_conv(s, prefix, w):
    T = s.shape[1]
    sf = jnp.concatenate([prefix.astype(s.dtype), s], axis=1)
    y = sum(sf[:, j:j + T] * w[j] for j in range(CONV_WIDTH))
    return y, sf[:, -(CONV_WIDTH - 1):]


def layer_forward(h, p_l, conv_prefix, attend, norm_g, w1_gate, w1_up, w1_down, w_in, conv_w,
                  w_att_out, w_conv_out, w_out, w2_gate, w2_up, w2_down, w_ple_gate, w_ple_proj):
    Bn, T, _ = h.shape
    h = h + 0.5 * rmsnorm(swiglu(rmsnorm(h, norm_g[0]), w1_gate, w1_up, w1_down), norm_g[1])
    u = rmsnorm(h, norm_g[2])
    z = u @ w_in
    q, k, v, x_in, b_gate, c_gate, g_att, g_conv = jnp.split(z, SPLITS, axis=-1)
    q = q.reshape(Bn, T, N_HEADS, HEAD_DIM)
    k = k.reshape(Bn, T, N_HEADS, HEAD_DIM)
    v = v.reshape(Bn, T, N_HEADS, HEAD_DIM)
    o_att = attend(q, k, v)
    conv_y, conv_state = short_conv(c_gate * x_in, conv_prefix, conv_w)
    y_conv = b_gate * conv_y
    m = jax.nn.sigmoid(g_att) * (o_att @ w_att_out) + jax.nn.sigmoid(g_conv) * (y_conv @ w_conv_out)
    h = h + rmsnorm(m @ w_out, norm_g[3])
    h = h + 0.5 * rmsnorm(swiglu(rmsnorm(h, norm_g[4]), w2_gate, w2_up, w2_down), norm_g[5])
    h = h + rmsnorm(jax.nn.sigmoid(h @ w_ple_gate) * (p_l @ w_ple_proj), norm_g[6])
    return h, k, v, conv_state


def setup_inputs(seed: int = 0) -> dict:
    key = jax.random.key(seed)
    ks = jax.random.split(key, 24)
    f32 = jnp.float32
    att_cache = min(ATT_WINDOW, PAST_LEN)

    def w(k, shape, fan_in):
        return jax.random.normal(k, shape, f32) * (fan_in ** -0.5)

    return {
        "x_prompt": jax.random.normal(ks[0], (BATCH, SEQ, D_MODEL), f32),
        "x_sample": jax.random.normal(ks[1], (DEC_BATCH, DEC_SEQ, D_MODEL), f32),
        "cache_k": jax.random.normal(ks[2], (DEPTH, DEC_BATCH, att_cache, N_HEADS, HEAD_DIM), f32),
        "cache_v": jax.random.normal(ks[3], (DEPTH, DEC_BATCH, att_cache, N_HEADS, HEAD_DIM), f32),
        "cache_conv": jax.random.normal(ks[4], (DEPTH, DEC_BATCH, CONV_WIDTH - 1, D_CONV), f32),
        "p_prompt": jax.random.normal(ks[5], (DEPTH, BATCH, SEQ, D_PLE), f32),
        "p_sample": jax.random.normal(ks[6], (DEPTH, DEC_BATCH, DEC_SEQ, D_PLE), f32),
        "norm_g": 1.0 + 0.05 * jax.random.normal(ks[7], (DEPTH, N_NORMS, D_MODEL), f32),
        "w1_gate": w(ks[8], (DEPTH, D_MODEL, D_FF), D_MODEL),
        "w1_up": w(ks[9], (DEPTH, D_MODEL, D_FF), D_MODEL),
        "w1_down": w(ks[10], (DEPTH, D_FF, D_MODEL), D_FF),
        "w_in": w(ks[11], (DEPTH, D_MODEL, D_IN), D_MODEL),
        "conv_w": w(ks[12], (DEPTH, CONV_WIDTH, D_CONV), CONV_WIDTH),
        "rel_bias": 0.2 * jax.random.normal(ks[13], (DEPTH, N_HEADS, 2 * MAX_REL + 1), f32),
        "w_att_out": w(ks[14], (DEPTH, D_ATT, D_MODEL), D_ATT),
        "w_conv_out": w(ks[15], (DEPTH, D_CONV, D_MODEL), D_CONV),
        "w_out": w(ks[16], (DEPTH, D_MODEL, D_MODEL), D_MODEL),
        "w2_gate": w(ks[17], (DEPTH, D_MODEL, D_FF), D_MODEL),
        "w2_up": w(ks[18], (DEPTH, D_MODEL, D_FF), D_MODEL),
        "w2_down": w(ks[19], (DEPTH, D_FF, D_MODEL), D_FF),
        "w_ple_gate": w(ks[20], (DEPTH, D_MODEL, D_MODEL), D_MODEL),
        "w_ple_proj": w(ks[21], (DEPTH, D_PLE, D_MODEL), D_PLE),
    }


def reference(x_prompt, x_sample, cache_k, cache_v, cache_conv, p_prompt, p_sample, norm_g,
              w1_gate, w1_up, w1_down, w_in, conv_w, rel_bias, w_att_out, w_conv_out, w_out,
              w2_gate, w2_up, w2_down, w_ple_gate, w_ple_proj):
    hp, hs = x_prompt, x_sample
    kp_l, vp_l, cp_l, ks_l, vs_l, cs_l = [], [], [], [], [], []
    for l in range(DEPTH):
        weights = (norm_g[l], w1_gate[l], w1_up[l], w1_down[l], w_in[l], conv_w[l],
                   w_att_out[l], w_conv_out[l], w_out[l], w2_gate[l], w2_up[l], w2_down[l],
                   w_ple_gate[l], w_ple_proj[l])
        attend_p = functools.partial(chunk_band_attention, table=rel_bias[l])
        prefix_p = jnp.zeros((hp.shape[0], CONV_WIDTH - 1, D_CONV), hp.dtype)
        hp, k_p, v_p, c_p = layer_forward(hp, p_prompt[l], prefix_p, attend_p, *weights)
        keep = min(ATT_WINDOW, k_p.shape[1])
        kp_l.append(k_p[:, -keep:])
        vp_l.append(v_p[:, -keep:])
        cp_l.append(c_p)
        attend_s = functools.partial(cached_band_attention, k_cache=cache_k[l], v_cache=cache_v[l],
                                     table=rel_bias[l])
        hs, k_s, v_s, c_s = layer_forward(hs, p_sample[l], cache_conv[l], attend_s, *weights)
        ks_l.append(k_s)
        vs_l.append(v_s)
        cs_l.append(c_s)
    return (hp, hs, jnp.stack(kp_l), jnp.stack(vp_l), jnp.stack(cp_l),
            jnp.stack(ks_l), jnp.stack(vs_l), jnp.stack(cs_l))
```

```cpp
#include <hip/hip_runtime.h>
#include <hip/hip_cooperative_groups.h>
#include <cstdio>
#include <cstdint>
namespace cg = cooperative_groups;

#define LAS __attribute__((address_space(3)))
typedef unsigned short bf16_t;
typedef short bf16x8 __attribute__((ext_vector_type(8)));
typedef short s16x4 __attribute__((ext_vector_type(4)));
typedef float f32x4 __attribute__((ext_vector_type(4)));
typedef float f32x16 __attribute__((ext_vector_type(16)));
typedef unsigned u32x4 __attribute__((ext_vector_type(4)));
typedef unsigned u32x2 __attribute__((ext_vector_type(2)));

constexpr int MP = 65536, MS = 512, MT = MP + MS;
constexpr int D = 1024, FF = 2816, DIN = 5120, DA = 512, DPLE = 256;
constexpr int SEQ = 8192, NB = 8, SB = 32, ST = 16, SKV = 576;
constexpr int KROWS = MP + SB * SKV;
constexpr float EPS = 1e-6f;

constexpr size_t O_Y = 0;
constexpr size_t O_KP = (size_t)MT * D;
constexpr size_t O_VP = O_KP + (size_t)NB * 512 * 512;
constexpr size_t O_CP = O_VP + (size_t)NB * 512 * 512;
constexpr size_t O_KS = O_CP + (size_t)NB * 2 * 512;
constexpr size_t O_VS = O_KS + (size_t)SB * ST * 512;
constexpr size_t O_CS = O_VS + (size_t)SB * ST * 512;
constexpr size_t O_END = O_CS + (size_t)SB * 2 * 512;

constexpr size_t WS_W1GU = 0;
constexpr size_t WS_W1D  = WS_W1GU + (size_t)2 * FF * D * 2;
constexpr size_t WS_WIN  = WS_W1D + (size_t)D * FF * 2;
constexpr size_t WS_WAO  = WS_WIN + (size_t)DIN * D * 2;
constexpr size_t WS_WCO  = WS_WAO + (size_t)D * DA * 2;
constexpr size_t WS_WOUT = WS_WCO + (size_t)D * DA * 2;
constexpr size_t WS_W2GU = WS_WOUT + (size_t)D * D * 2;
constexpr size_t WS_W2D  = WS_W2GU + (size_t)2 * FF * D * 2;
constexpr size_t WS_WPG  = WS_W2D + (size_t)D * FF * 2;
constexpr size_t WS_WPP  = WS_WPG + (size_t)D * D * 2;
constexpr size_t WS_PB   = WS_WPP + (size_t)D * DPLE * 2;
constexpr size_t WS_AN   = WS_PB + (size_t)MT * DPLE * 2;
constexpr size_t WS_F    = WS_AN + (size_t)MT * D * 2;
constexpr size_t WS_BIG  = WS_F + (size_t)MT * D * 2;
constexpr size_t WS_ACT  = WS_BIG;
constexpr size_t WS_Q    = WS_BIG;
constexpr size_t WS_K    = WS_Q + (size_t)MT * 512 * 2;
constexpr size_t WS_VT   = WS_K + (size_t)KROWS * 512 * 2;
constexpr size_t WS_VTS  = WS_VT + (size_t)NB * 512 * SEQ * 2;
constexpr size_t WS_S    = WS_VTS + (size_t)SB * 512 * SKV * 2;
constexpr size_t WS_BG   = WS_S + (size_t)MT * 512 * 2;
constexpr size_t WS_SA   = WS_BG + (size_t)MT * 512 * 2;
constexpr size_t WS_SC   = WS_SA + (size_t)MT * D * 2;
constexpr size_t WS_END  = WS_SC + (size_t)MT * D * 2;
constexpr size_t WS_MM   = WS_Q;
constexpr size_t WS_ATT  = WS_F;
constexpr size_t WS_YC   = WS_F + (size_t)MT * 512 * 2;
static_assert(WS_ACT + (size_t)MT * FF * 2 <= WS_END, "act overlay");
static_assert(WS_MM + (size_t)MT * D * 2 <= WS_S, "mm overlay");
constexpr size_t WS_CTL = WS_END, CTL_WORDS_BYTES = 32768, SS_BYTES = (size_t)2 * MT * 4, CTL_BYTES = CTL_WORDS_BYTES + SS_BYTES;
constexpr size_t WS_SS = WS_CTL + CTL_WORDS_BYTES;
constexpr size_t WS_FS = WS_CTL + CTL_BYTES, FS_ONE = (size_t)MS * D * 4;
constexpr size_t WS_RS = WS_FS + 11 * FS_ONE;
constexpr size_t WS_X = WS_RS + (size_t)3 * MT * 4;
constexpr size_t WS_TOTAL = WS_X + (size_t)4 * 258 * 4 * 256 * 4;
static_assert(WS_TOTAL <= ((size_t)1 << 30), "workspace");

constexpr int LDS_BYTES = 131072 + 1024 + 4096 + 1024;

__device__ __forceinline__ unsigned cvt_pk_bf16(float lo, float hi) { unsigned r; asm volatile("v_cvt_pk_bf16_f32 %0, %1, %2" : "=v"(r) : "v"(lo), "v"(hi)); return r; }
__device__ __forceinline__ float bf_lo(unsigned u) { return __builtin_bit_cast(float, u << 16); }
__device__ __forceinline__ float bf_hi(unsigned u) { return __builtin_bit_cast(float, u & 0xffff0000u); }
__device__ __forceinline__ float sigmoidf_(float x) { return __builtin_amdgcn_rcpf(1.f + __expf(-x)); }
__device__ __forceinline__ int tid_now() { int t = threadIdx.x; asm volatile("" : "+v"(t)); return t; }
__device__ __forceinline__ float wave_sum(float v) {
#pragma unroll
    for (int o = 32; o >= 1; o >>= 1) v += __shfl_xor(v, o);
    return v;
}

namespace pg8 {
constexpr int BM = 256, BK = 64, HALF = 128, HTB = HALF * BK * 2, STAGE_BYTES = 8 * HTB, NXCD = 8, WGM = 4;
__host__ __device__ __forceinline__ int lds_byte(int r, int c) { const int st = (r >> 4) * 2 + (c >> 5), rr = r & 15, cc = c & 31, ob = rr * 64 + cc * 2; return st * 1024 + (ob ^ (((ob >> 9) & 1) << 5)); }
__host__ __device__ __forceinline__ void stage_rc(int b, int& R, int& C) { const int st = b / 1024, sb = b % 1024, swz = sb ^ (((sb >> 9) & 1) << 5); R = (st >> 1) * 16 + swz / 64; C = (st & 1) * 32 + (swz % 64) / 2; }
__host__ __device__ __forceinline__ int perm32(int rho) { const int n = rho >> 4, i = rho & 15; return 8 * (i >> 2) + 4 * n + (i & 3); }

struct Unit { int pm, pn; };
struct Gemm { const bf16_t* A; const bf16_t* Bt; int K, ld; };

struct StaticOrder {
    int nM, nN, nwg, G, c;
    __host__ __device__ void init(int M, int N, int G_, int c_) { nM = M / BM; nN = N / BM; nwg = nM * nN; G = G_; c = c_; }
    __host__ __device__ bool next(int i, Unit& u) const {
        const long L = (long)i * G + c; if (L >= nwg) return false;
        int wgid = (int)L; { const int q = nwg / NXCD, r = nwg % NXCD, xcd = wgid % NXCD, off = wgid / NXCD; wgid = (xcd < r ? xcd * (q + 1) : r * (q + 1) + (xcd - r) * q) + off; }
        const int nig = WGM * nN, gid = wgid / nig, fm = gid * WGM, gsz = (nM - fm) < WGM ? (nM - fm) : WGM;
        u.pm = fm + ((wgid % nig) % gsz); u.pn = (wgid % nig) / gsz; return true;
    }
};

template <class Epi, class Sched>
__device__ __forceinline__ void gemm_phase(LAS unsigned char* lds, const Gemm g, const Sched& S, const Epi& E) {
    int tid_ = threadIdx.x; asm volatile("" : "+v"(tid_));
    const int tid = tid_, wid = __builtin_amdgcn_readfirstlane(tid >> 6), lane = tid & 63, wr = wid >> 2, wc = wid & 3, fr = lane & 15, fq = lane >> 4;
    const int K = g.K, ld = g.ld, nt = K / BK;
    unsigned voffA[2], voffB[2];
#pragma unroll
    for (int i = 0; i < 2; ++i) { int R, C; stage_rc(tid * 16 + i * 8192, R, C); const int Rb = (R & ~31) + perm32(R & 31);
        voffA[i] = (unsigned)(R * ld + C) * 2u; voffB[i] = (unsigned)(Rb * ld + C) * 2u; }
    const size_t kstep = (size_t)(BK * 2);
    const size_t hstep = (size_t)HALF * ld * 2;
    const size_t tstep = 2 * hstep;
    const unsigned ldsw = (unsigned)wid * 1024u;
    const int aoff = lds_byte(wr * 64 + fr, fq * 8), boff = lds_byte(wc * 32 + fr, fq * 8);
#define PG8_SA(b, h) (((b) * 2 + (h)) * HTB)
#define PG8_SB(b, h) ((4 + (b) * 2 + (h)) * HTB)
#define PG8_STAGE(bufoff, gbase, voff) do { _Pragma("unroll") for (int _i = 0; _i < 2; ++_i) \
        __builtin_amdgcn_global_load_lds((const unsigned*)((const char*)(gbase) + (voff)[_i]), (LAS unsigned*)(lds + (bufoff) + ldsw + _i * 8192), 16, 0, 0); } while (0)
#define PG8_LDA(dst, b, h) do { _Pragma("unroll") for (int m = 0; m < 4; ++m) _Pragma("unroll") for (int k = 0; k < 2; ++k) dst[m][k] = *(const LAS bf16x8*)(lds + PG8_SA(b, h) + aoff + m * 2048 + k * 1024); } while (0)
#define PG8_LDB(dst, b, h) do { _Pragma("unroll") for (int n = 0; n < 2; ++n) _Pragma("unroll") for (int k = 0; k < 2; ++k) dst[n][k] = *(const LAS bf16x8*)(lds + PG8_SB(b, h) + boff + n * 2048 + k * 1024); } while (0)
#define PG8_MMA(ai, bj, At, Bt) do { __builtin_amdgcn_s_setprio(1); _Pragma("unroll") for (int m = 0; m < 4; ++m) _Pragma("unroll") for (int n = 0; n < 2; ++n) _Pragma("unroll") for (int k = 0; k < 2; ++k) \
        acc[ai][bj][m][n] = __builtin_amdgcn_mfma_f32_16x16x32_bf16(Bt[n][k], At[m][k], acc[ai][bj][m][n], 0, 0, 0); __builtin_amdgcn_s_setprio(0); } while (0)
#define PG8_WAIT_V(n) asm volatile("s_waitcnt vmcnt(" #n ")" ::: "memory")
#define PG8_WAIT_L(n) asm volatile("s_waitcnt lgkmcnt(" #n ")" ::: "memory")
#define PG8_BAR __builtin_amdgcn_s_barrier()
#define PG8_SCHED __builtin_amdgcn_sched_barrier(0)
    Unit cur, nxt; int ui = 0;
    if (!S.next(0, cur)) return;
    f32x4 acc[2][2][4][2];
#pragma unroll
    for (int a = 0; a < 2; ++a)
#pragma unroll
        for (int b = 0; b < 2; ++b)
#pragma unroll
            for (int m = 0; m < 4; ++m)
#pragma unroll
                for (int n = 0; n < 2; ++n) acc[a][b][m][n] = (f32x4){0.f, 0.f, 0.f, 0.f};
    bf16x8 At[4][2], B0[2][2], B1[2][2];
    const char* cA = (const char*)g.A + (size_t)cur.pm * tstep; const char* cB = (const char*)g.Bt + (size_t)cur.pn * tstep;
    PG8_STAGE(PG8_SB(0, 0), cB, voffB); PG8_STAGE(PG8_SB(0, 1), cB + hstep, voffB); PG8_STAGE(PG8_SA(0, 0), cA, voffA); PG8_STAGE(PG8_SA(0, 1), cA + hstep, voffA);
    if (wr == 1) PG8_BAR;
    PG8_WAIT_V(2); PG8_BAR;
    PG8_STAGE(PG8_SB(1, 0), cB + kstep, voffB); PG8_STAGE(PG8_SA(1, 0), cA + kstep, voffA); PG8_STAGE(PG8_SB(1, 1), cB + hstep + kstep, voffB);
    PG8_WAIT_V(6); PG8_BAR;
    for (;;) {
        const bool has_next = S.next(ui + 1, nxt);
        const char* nA = has_next ? (const char*)g.A + (size_t)nxt.pm * tstep : cA; const char* nB = has_next ? (const char*)g.Bt + (size_t)nxt.pn * tstep : cB;
        for (int t = 0; t < nt; t += 2) {
            const bool last = (t == nt - 2);
            const char* a1 = cA + (size_t)(t + 1) * kstep;
            const char* a2 = last ? nA : cA + (size_t)(t + 2) * kstep; const char* b2 = last ? nB : cB + (size_t)(t + 2) * kstep;
            const char* a3 = a2 + kstep; const char* b3 = b2 + kstep;
            PG8_LDB(B0, 0, 0); PG8_LDB(B1, 0, 1); PG8_SCHED; PG8_LDA(At, 0, 0); PG8_STAGE(PG8_SA(1, 1), a1 + hstep, voffA);
            PG8_WAIT_V(8); PG8_WAIT_L(0); PG8_BAR; PG8_MMA(0, 0, At, B0); PG8_MMA(0, 1, At, B1); PG8_BAR; PG8_SCHED;
            PG8_LDA(At, 0, 1); PG8_STAGE(PG8_SB(0, 0), b2, voffB); PG8_STAGE(PG8_SB(0, 1), b2 + hstep, voffB); PG8_STAGE(PG8_SA(0, 0), a2, voffA);
            PG8_WAIT_V(8); PG8_WAIT_L(0); PG8_BAR; PG8_MMA(1, 0, At, B0); PG8_MMA(1, 1, At, B1); PG8_BAR; PG8_SCHED;
            PG8_LDB(B0, 1, 0); PG8_LDB(B1, 1, 1); PG8_SCHED; PG8_LDA(At, 1, 0); PG8_STAGE(PG8_SA(0, 1), a2 + hstep, voffA);
            PG8_WAIT_V(8); PG8_WAIT_L(0); PG8_BAR; PG8_MMA(0, 0, At, B0); PG8_MMA(0, 1, At, B1); PG8_BAR; PG8_SCHED;
            PG8_LDA(At, 1, 1); PG8_STAGE(PG8_SB(1, 0), b3, voffB); PG8_STAGE(PG8_SB(1, 1), b3 + hstep, voffB); PG8_STAGE(PG8_SA(1, 0), a3, voffA);
            PG8_WAIT_V(8); PG8_WAIT_L(0); PG8_BAR; PG8_MMA(1, 0, At, B0); PG8_MMA(1, 1, At, B1); PG8_BAR; PG8_SCHED;
        }
        if (wr == 0) PG8_BAR;
        E(acc, cur, wr, wc, fr, fq);
        if (!has_next) break;
#pragma unroll
        for (int a = 0; a < 2; ++a)
#pragma unroll
            for (int b = 0; b < 2; ++b)
#pragma unroll
                for (int m = 0; m < 4; ++m)
#pragma unroll
                    for (int n = 0; n < 2; ++n) acc[a][b][m][n] = (f32x4){0.f, 0.f, 0.f, 0.f};
        cur = nxt; cA = nA; cB = nB; ++ui;
        if (wr == 1) PG8_BAR;
    }
    PG8_WAIT_V(0);
    PG8_BAR;
#undef PG8_SA
#undef PG8_SB
#undef PG8_STAGE
#undef PG8_LDA
#undef PG8_LDB
#undef PG8_MMA
#undef PG8_WAIT_V
#undef PG8_WAIT_L
#undef PG8_BAR
#undef PG8_SCHED
}

typedef f32x4 Acc[2][2][4][2];
struct OneUnit { int pm, pn; bool valid;
    __device__ __forceinline__ bool next(int i, Unit& u) const { if (i != 0 || !valid) return false; u.pm = pm; u.pn = pn; return true; } };

__device__ __forceinline__ u32x4 pack8(const f32x4 a, const f32x4 b) {
    u32x4 w; w.x = cvt_pk_bf16(a[0], a[1]); w.y = cvt_pk_bf16(a[2], a[3]); w.z = cvt_pk_bf16(b[0], b[1]); w.w = cvt_pk_bf16(b[2], b[3]); return w;
}
__device__ __forceinline__ void unpack8(const u32x4 w, f32x4& a, f32x4& b) {
    a = (f32x4){bf_lo(w.x), bf_hi(w.x), bf_lo(w.y), bf_hi(w.y)}; b = (f32x4){bf_lo(w.z), bf_hi(w.z), bf_lo(w.w), bf_hi(w.w)};
}

template <int MODE> struct EpiStd {
    bf16_t* O; const bf16_t* G; int ldc;
    __device__ __forceinline__ void operator()(const Acc& acc, const Unit& u, int wr, int wc, int fr, int fq) const {
        const int row0 = u.pm * BM + wr * 64 + fr, col0 = u.pn * BM + wc * 32 + 8 * fq;
#pragma unroll
        for (int ai = 0; ai < 2; ++ai)
#pragma unroll
            for (int m = 0; m < 4; ++m) {
                const size_t ro = (size_t)(row0 + ai * HALF + m * 16) * ldc + col0;
#pragma unroll
                for (int bj = 0; bj < 2; ++bj) {
                    f32x4 v0 = acc[ai][bj][m][0], v1 = acc[ai][bj][m][1];
                    if (MODE == 1 || MODE == 2) { f32x4 g0, g1; unpack8(*(const u32x4*)(G + ro + bj * HALF), g0, g1); v0 = v0 * g0; v1 = v1 * g1; }
                    if (MODE == 2) { f32x4 o0, o1; unpack8(*(const u32x4*)(O + ro + bj * HALF), o0, o1); v0 = v0 + o0; v1 = v1 + o1; }
                    if (MODE == 3) { f32x4 o0, o1; unpack8(*(const u32x4*)(O + ro + bj * HALF), o0, o1);
#pragma unroll
                        for (int i = 0; i < 4; ++i) { v0[i] = sigmoidf_(v0[i]) * o0[i]; v1[i] = sigmoidf_(v1[i]) * o1[i]; } }
                    *(u32x4*)(O + ro + bj * HALF) = pack8(v0, v1);
                }
            }
    }
};

struct EpiPartialG {
    float* FS; const bf16_t* G;
    __device__ __forceinline__ void operator()(const Acc& acc, const Unit& u, int wr, int wc, int fr, int fq) const {
        const int rl0 = (u.pm - MP / BM) * BM + wr * 64 + fr, col0 = u.pn * BM + wc * 32 + 8 * fq;
#pragma unroll
        for (int ai = 0; ai < 2; ++ai)
#pragma unroll
            for (int m = 0; m < 4; ++m) {
                const int rl = rl0 + ai * HALF + m * 16;
                float* p = FS + (size_t)rl * D + col0; const bf16_t* gp = G + (size_t)(MP + rl) * D + col0;
#pragma unroll
                for (int bj = 0; bj < 2; ++bj) { f32x4 g0, g1; unpack8(*(const u32x4*)(gp + bj * HALF), g0, g1);
                    *(f32x4*)(p + bj * HALF) = acc[ai][bj][m][0] * g0; *(f32x4*)(p + bj * HALF + 4) = acc[ai][bj][m][1] * g1; }
            }
    }
};

struct EpiPartial {
    float* FS;
    __device__ __forceinline__ void operator()(const Acc& acc, const Unit& u, int wr, int wc, int fr, int fq) const {
        const int row0 = (u.pm - MP / BM) * BM + wr * 64 + fr, col0 = u.pn * BM + wc * 32 + 8 * fq;
#pragma unroll
        for (int ai = 0; ai < 2; ++ai)
#pragma unroll
            for (int m = 0; m < 4; ++m) {
                float* p = FS + (size_t)(row0 + ai * HALF + m * 16) * D + col0;
#pragma unroll
                for (int bj = 0; bj < 2; ++bj) { *(f32x4*)(p + bj * HALF) = acc[ai][bj][m][0]; *(f32x4*)(p + bj * HALF + 4) = acc[ai][bj][m][1]; }
            }
    }
};

struct EpiGateUp {
    bf16_t* O; const float* rs; const float* ss;
    __device__ __forceinline__ void operator()(const Acc& acc, const Unit& u, int wr, int wc, int fr, int fq) const {
        const int row0 = u.pm * BM + wr * 64 + fr, col0 = u.pn * HALF + wc * 32 + 8 * fq;
#pragma unroll
        for (int ai = 0; ai < 2; ++ai)
#pragma unroll
            for (int m = 0; m < 4; ++m) {
                f32x4 v0, v1; const int rrow = row0 + ai * HALF + m * 16; const float rr = (ss != nullptr && u.pm < MP / BM) ? __builtin_amdgcn_rsqf(ss[rrow] * (1.f / D) + EPS) : rs[rrow];
#pragma unroll
                for (int i = 0; i < 4; ++i) { const float g0 = acc[ai][0][m][0][i] * rr, g1 = acc[ai][0][m][1][i] * rr;
                    v0[i] = g0 * sigmoidf_(g0) * (acc[ai][1][m][0][i] * rr); v1[i] = g1 * sigmoidf_(g1) * (acc[ai][1][m][1][i] * rr); }
                *(u32x4*)(O + (size_t)(row0 + ai * HALF + m * 16) * FF + col0) = pack8(v0, v1);
            }
    }
};

struct EpiWin {
    bf16_t *Q, *Kb, *Vt, *Vts, *Sb, *Bg, *SA, *SC; float* out; const float* rstd_; const float* ss;
    __device__ __forceinline__ float rstd_of(int r) const { return r < MP ? __builtin_amdgcn_rsqf(ss[r] * (1.f / D) + EPS) : rstd_[r]; }
    __device__ __forceinline__ void operator()(const Acc& acc, const Unit& u, int wr, int wc, int fr, int fq) const {
        const int pn = u.pn, pm = u.pm;
        const int row0 = pm * BM + wr * 64 + fr, cl0 = wc * 32 + 8 * fq;
        const bool samp = pm >= MP / BM;
        if (pn < 2 || pn >= 10) {
            bf16_t* base; int ldc, colt; float sc = 1.f; bool sg = false;
            if (pn < 2) { base = Q; ldc = 512; colt = pn * 256; sc = 0.125f * 1.4426950408889634f; }
            else if (pn < 12) { base = Bg; ldc = 512; colt = (pn - 10) * 256; }
            else if (pn < 16) { base = SA; ldc = 1024; colt = (pn - 12) * 256; sg = true; }
            else { base = SC; ldc = 1024; colt = (pn - 16) * 256; sg = true; }
#pragma unroll
            for (int ai = 0; ai < 2; ++ai)
#pragma unroll
                for (int m = 0; m < 4; ++m) {
                    const size_t ro = (size_t)(row0 + ai * HALF + m * 16) * ldc + colt + cl0; const float rr = sc * rstd_of(row0 + ai * HALF + m * 16);
#pragma unroll
                    for (int bj = 0; bj < 2; ++bj) {
                        f32x4 v0 = acc[ai][bj][m][0] * rr, v1 = acc[ai][bj][m][1] * rr;
                        if (sg) {
#pragma unroll
                            for (int i = 0; i < 4; ++i) { v0[i] = sigmoidf_(v0[i]); v1[i] = sigmoidf_(v1[i]); } }
                        *(u32x4*)(base + ro + bj * HALF) = pack8(v0, v1);
                    }
                }
        } else if (pn < 4) {
            const int colt = (pn - 2) * 256 + cl0;
            const bool wout = samp || ((pm & 31) >= 30);
#pragma unroll
            for (int ai = 0; ai < 2; ++ai)
#pragma unroll
                for (int m = 0; m < 4; ++m) {
                    const int r = row0 + ai * HALF + m * 16;
                    size_t krow, orow;
                    if (samp) { const int rs = r - MP; krow = (size_t)MP + (size_t)(rs >> 4) * SKV + 512 + (rs & 15); orow = O_KS + (size_t)rs * 512; }
                    else { krow = r; orow = O_KP + ((size_t)(r >> 13) * 512 + ((r & 8191) - 7680)) * 512; }
                    const float rr = rstd_of(r);
#pragma unroll
                    for (int bj = 0; bj < 2; ++bj) {
                        const f32x4 v0 = acc[ai][bj][m][0] * rr, v1 = acc[ai][bj][m][1] * rr;
                        *(u32x4*)(Kb + krow * 512 + colt + bj * HALF) = pack8(v0, v1);
                        if (wout) { *(f32x4*)(out + orow + colt + bj * HALF) = v0; *(f32x4*)(out + orow + colt + bj * HALF + 4) = v1; }
                    }
                }
        } else if (pn < 6) {
            const int colt = (pn - 4) * 256 + cl0;
            const bool wout = samp || ((pm & 31) >= 30);
#pragma unroll
            for (int ai = 0; ai < 2; ++ai)
#pragma unroll
                for (int m = 0; m < 4; ++m) {
                    const int r = row0 + ai * HALF + m * 16;
                    bf16_t* vb; size_t pitch, orow;
                    if (samp) { const int rs = r - MP; vb = Vts + (size_t)(rs >> 4) * 512 * SKV + 512 + (rs & 15); pitch = SKV; orow = O_VS + (size_t)rs * 512; }
                    else { vb = Vt + (size_t)(r >> 13) * 512 * SEQ + (r & 8191); pitch = SEQ; orow = O_VP + ((size_t)(r >> 13) * 512 + ((r & 8191) - 7680)) * 512; }
                    const float rr = rstd_of(r);
#pragma unroll
                    for (int bj = 0; bj < 2; ++bj) {
#pragma unroll
                        for (int n = 0; n < 2; ++n) {
                            const f32x4 vv = acc[ai][bj][m][n] * rr;
                            const unsigned p0 = cvt_pk_bf16(vv[0], vv[1]), p1 = cvt_pk_bf16(vv[2], vv[3]);
                            bf16_t* vp = vb + (size_t)(colt + bj * HALF + 4 * n) * pitch;
                            vp[0] = (bf16_t)(p0 & 0xffffu); vp[pitch] = (bf16_t)(p0 >> 16); vp[2 * pitch] = (bf16_t)(p1 & 0xffffu); vp[3 * pitch] = (bf16_t)(p1 >> 16);
                        }
                        if (wout) { *(f32x4*)(out + orow + colt + bj * HALF) = acc[ai][bj][m][0] * rr; *(f32x4*)(out + orow + colt + bj * HALF + 4) = acc[ai][bj][m][1] * rr; }
                    }
                }
        } else {
            const int colt = (pn - 6) * 128 + cl0;
#pragma unroll
            for (int ai = 0; ai < 2; ++ai)
#pragma unroll
                for (int m = 0; m < 4; ++m) {
                    const int r = row0 + ai * HALF + m * 16;
                    const float rr = rstd_of(r), rr2 = rr * rr;
                    const f32x4 v0 = acc[ai][0][m][0] * acc[ai][1][m][0] * rr2, v1 = acc[ai][0][m][1] * acc[ai][1][m][1] * rr2;
                    *(u32x4*)(Sb + (size_t)r * 512 + colt) = pack8(v0, v1);
                    if (samp) { const int rs = r - MP; if ((rs & 15) >= 14) { float* o = out + O_CS + ((size_t)(rs >> 4) * 2 + ((rs & 15) - 14)) * 512 + colt; *(f32x4*)o = v0; *(f32x4*)(o + 4) = v1; } }
                    else if ((r & 8191) >= 8190) { float* o = out + O_CP + ((size_t)(r >> 13) * 2 + ((r & 8191) - 8190)) * 512 + colt; *(f32x4*)o = v0; *(f32x4*)(o + 4) = v1; }
                }
        }
    }
};
}

struct Args { const float* in[22]; float* out; unsigned char* ws; int ph_lo, ph_hi; };
enum { I_XP = 0, I_XS, I_CK, I_CV, I_CC, I_PP, I_PS, I_NG, I_W1G, I_W1U, I_W1D, I_WIN, I_CW, I_RB, I_WAO, I_WCO, I_WOUT, I_W2G, I_W2U, I_W2D, I_WPG, I_WPP };

__device__ __forceinline__ void tr_tile(LAS float* t, const float* src, int ldS, int k0, int c0, bf16_t* dst, int ldD, int r0, const float* gk) {
    const int tid = threadIdx.x, ty = tid >> 4, tx = tid & 15;
#pragma unroll
    for (int i = 0; i < 2; ++i) { const int k = ty + 32 * i; f32x4 v = *(const f32x4*)(src + (size_t)(k0 + k) * ldS + c0 + 4 * tx); if (gk) v = v * gk[k0 + k];
        t[k * 65 + 4 * tx + 0] = v[0]; t[k * 65 + 4 * tx + 1] = v[1]; t[k * 65 + 4 * tx + 2] = v[2]; t[k * 65 + 4 * tx + 3] = v[3]; }
    __syncthreads();
    const int c = tid >> 3, kk = (tid & 7) * 8;
    u32x4 w;
    w.x = cvt_pk_bf16(t[(kk + 0) * 65 + c], t[(kk + 1) * 65 + c]); w.y = cvt_pk_bf16(t[(kk + 2) * 65 + c], t[(kk + 3) * 65 + c]);
    w.z = cvt_pk_bf16(t[(kk + 4) * 65 + c], t[(kk + 5) * 65 + c]); w.w = cvt_pk_bf16(t[(kk + 6) * 65 + c], t[(kk + 7) * 65 + c]);
    *(u32x4*)(dst + (size_t)(r0 + c) * ldD + k0 + kk) = w;
    __syncthreads();
}

template <class CMap>
__device__ __forceinline__ void tr_matrix(LAS float* t, int& job, int nw, int me, const float* src, int ldS, int K, int ncb, bf16_t* dst, int ldD, const CMap& cmap, const float* gk = nullptr) {
    const int nkb = K / 64, ntile = nkb * ncb;
    int first = (me - job % nw + nw) % nw;
    for (int i = first; i < ntile; i += nw) { const int cb = i / nkb, kb = i % nkb; int c0, r0; cmap(cb, c0, r0); tr_tile(t, src, ldS, kb * 64, c0, dst, ldD, r0, gk); }
    job += ntile;
}

struct NormP { const bf16_t* F; const float* FS; int nsplit; const bf16_t* hb_in; bf16_t* hb_out; float* fout; const float* gpost; float alpha; float* rs; bf16_t* AN; };
template <int HIN>
__device__ __forceinline__ void norm_load_h(const Args& a, const NormP& p, int r, int lane, f32x4 (&h)[4]) {
    if (HIN == 0) { const float* hin = r < MP ? a.in[I_XP] + (size_t)r * D : a.in[I_XS] + (size_t)(r - MP) * D;
#pragma unroll
        for (int i = 0; i < 4; ++i) h[i] = __builtin_nontemporal_load((const f32x4*)(hin + 256 * i + 4 * lane)); }
    else {
#pragma unroll
        for (int i = 0; i < 4; ++i) { const u32x2 w = __builtin_nontemporal_load((const u32x2*)(p.hb_in + (size_t)r * D + 256 * i + 4 * lane)); h[i] = (f32x4){bf_lo(w.x), bf_hi(w.x), bf_lo(w.y), bf_hi(w.y)}; } }
}
template <bool HAS_F, int OUTH, int ANM>
__device__ __forceinline__ void norm_finish(const NormP& p, int r, int lane, f32x4 (&h)[4], const f32x4 (&f)[4]) {
    if (HAS_F) {
        float ss = 0.f;
#pragma unroll
        for (int i = 0; i < 4; ++i) ss += f[i][0] * f[i][0] + f[i][1] * f[i][1] + f[i][2] * f[i][2] + f[i][3] * f[i][3];
        ss = wave_sum(ss);
        const float rs = p.alpha * __builtin_amdgcn_rsqf(ss * (1.f / D) + EPS);
#pragma unroll
        for (int i = 0; i < 4; ++i) { const f32x4 g = *(const f32x4*)(p.gpost + 256 * i + 4 * lane); h[i] = h[i] + f[i] * g * rs; }
    }
    if (OUTH == 2) {
#pragma unroll
        for (int i = 0; i < 4; ++i) __builtin_nontemporal_store(h[i], (f32x4*)(p.fout + (size_t)r * D + 256 * i + 4 * lane));
    }
    if (OUTH == 1) {
#pragma unroll
        for (int i = 0; i < 4; ++i) { u32x2 w; w.x = cvt_pk_bf16(h[i][0], h[i][1]); w.y = cvt_pk_bf16(h[i][2], h[i][3]); __builtin_nontemporal_store(w, (u32x2*)(p.hb_out + (size_t)r * D + 256 * i + 4 * lane)); }
    }
    if (ANM == 1) {
        float ss = 0.f;
#pragma unroll
        for (int i = 0; i < 4; ++i) ss += h[i][0] * h[i][0] + h[i][1] * h[i][1] + h[i][2] * h[i][2] + h[i][3] * h[i][3];
        ss = wave_sum(ss);
        if (lane == 0) p.rs[r] = __builtin_amdgcn_rsqf(ss * (1.f / D) + EPS);
    }
    if (ANM == 2) {
#pragma unroll
        for (int i = 0; i < 4; ++i) { u32x2 w; w.x = cvt_pk_bf16(h[i][0], h[i][1]); w.y = cvt_pk_bf16(h[i][2], h[i][3]); *(u32x2*)(p.AN + (size_t)r * D + 256 * i + 4 * lane) = w; }
    }
}
template <int HIN, bool HAS_F, int OUTH, int ANM>
__device__ __forceinline__ void norm_rows(const Args& a, const NormP p) {
    const int lane = threadIdx.x & 63, wv = threadIdx.x >> 6, G = gridDim.x;
    constexpr int NR = 8;
    const int rows_main = p.FS ? MP : MT;
    for (int rb = blockIdx.x * 8 + wv; rb < rows_main; rb += G * 8 * NR) {
        int rj[NR]; bool vj[NR];
#pragma unroll
        for (int j = 0; j < NR; ++j) { vj[j] = rb + j * G * 8 < rows_main; rj[j] = vj[j] ? rb + j * G * 8 : rb; }
        f32x4 h[NR][4], f[NR][4];
#pragma unroll
        for (int j = 0; j < NR; ++j) { const int r = rj[j];
            norm_load_h<HIN>(a, p, r, lane, h[j]);
            if (HAS_F) {
#pragma unroll
                for (int i = 0; i < 4; ++i) { const u32x2 w = __builtin_nontemporal_load((const u32x2*)(p.F + (size_t)r * D + 256 * i + 4 * lane)); f[j][i] = (f32x4){bf_lo(w.x), bf_hi(w.x), bf_lo(w.y), bf_hi(w.y)}; }
            }
        }
#pragma unroll
        for (int j = 0; j < NR; ++j) if (vj[j]) norm_finish<HAS_F, OUTH, ANM>(p, rj[j], lane, h[j], f[j]);
    }
    if (HAS_F && p.FS) {
        for (int r = MP + blockIdx.x * 8 + wv; r < MT; r += G * 8) {
            f32x4 h[4], f[4];
            norm_load_h<HIN>(a, p, r, lane, h);
#pragma unroll
            for (int i = 0; i < 4; ++i) { f32x4 v = *(const f32x4*)(p.FS + (size_t)(r - MP) * D + 256 * i + 4 * lane);
                for (int k = 1; k < p.nsplit; ++k) v = v + *(const f32x4*)(p.FS + ((size_t)k * MS + (r - MP)) * D + 256 * i + 4 * lane);
                f[i] = v; }
            norm_finish<HAS_F, OUTH, ANM>(p, r, lane, h, f);
        }
    }
}

constexpr int CW_PANEL = 4096, CW_PANEL_STRIDE = 512, CW_SAMPLE = CW_PANEL + 4 * CW_PANEL_STRIDE;
__device__ __forceinline__ unsigned cw_ld(unsigned* p)              { return __hip_atomic_load(p, __ATOMIC_RELAXED, __HIP_MEMORY_SCOPE_AGENT); }
__device__ __forceinline__ unsigned cw_add(unsigned* p, unsigned v) { return __hip_atomic_fetch_add(p, v, __ATOMIC_RELAXED, __HIP_MEMORY_SCOPE_AGENT); }
__device__ __forceinline__ void arrive_and_wait(unsigned* cnt, unsigned need, bool arrive, bool wait) {
    asm volatile("s_waitcnt vmcnt(0)" ::: "memory");
    __syncthreads();
    if (threadIdx.x == 0) {
        if (arrive) { __builtin_amdgcn_fence(__ATOMIC_RELEASE, "agent"); asm volatile("s_waitcnt vmcnt(0)" ::: "memory"); (void)cw_add(cnt, 1u); }
        if (wait) { unsigned sp = 0; while (cw_ld(cnt) < need) { __builtin_amdgcn_s_sleep(1); if (++sp > (1u << 24)) break; }
            __builtin_amdgcn_fence(__ATOMIC_ACQUIRE, "agent"); asm volatile("s_waitcnt vmcnt(0)" ::: "memory"); }
    }
    __syncthreads();
}

template <int PH>
struct EpiX {
    unsigned char* ws; float* out; const float* ng; LAS unsigned char* lds;
    __device__ __forceinline__ void operator()(f32x4 (&acc)[2][2][4][2], const pg8::Unit& u, int wr, int wc, int fr, int fq) const {
        using namespace pg8;
        const int tid = threadIdx.x;
        LAS float* lpart = (LAS float*)(lds + 131072 + 1024);
        LAS float* lrs = lpart + 1024;
        const float* gpost = ng + (PH == 0 ? 1 : PH == 1 ? 3 : PH == 2 ? 5 : 6) * D;
        const float alpha = (PH == 0 || PH == 2) ? 0.5f : 1.f;
        const bf16_t* hin = PH == 3 ? (const bf16_t*)(ws + WS_AN) : (const bf16_t*)out;
        const int rloc0 = wr * 64 + fr, col0 = u.pn * BM + wc * 32 + 8 * fq;
        if (PH == 3) {
            const bf16_t* P = (const bf16_t*)(ws + WS_F);
#pragma unroll
            for (int ai = 0; ai < 2; ++ai)
#pragma unroll
                for (int m = 0; m < 4; ++m) { const size_t ro = (size_t)(u.pm * BM + rloc0 + ai * HALF + m * 16) * D + col0;
#pragma unroll
                    for (int bj = 0; bj < 2; ++bj) { f32x4 p0, p1; unpack8(*(const u32x4*)(P + ro + bj * HALF), p0, p1);
#pragma unroll
                        for (int i = 0; i < 4; ++i) { acc[ai][bj][m][0][i] = sigmoidf_(acc[ai][bj][m][0][i]) * p0[i]; acc[ai][bj][m][1][i] = sigmoidf_(acc[ai][bj][m][1][i]) * p1[i]; } } }
        }
#pragma unroll
        for (int ai = 0; ai < 2; ++ai)
#pragma unroll
            for (int m = 0; m < 4; ++m) {
                float sq = 0.f;
#pragma unroll
                for (int bj = 0; bj < 2; ++bj)
#pragma unroll
                    for (int n = 0; n < 2; ++n)
#pragma unroll
                        for (int i = 0; i < 4; ++i) sq += acc[ai][bj][m][n][i] * acc[ai][bj][m][n][i];
                sq += __shfl_xor(sq, 16); sq += __shfl_xor(sq, 32);
                if (fq == 0) lpart[wc * 256 + rloc0 + ai * HALF + m * 16] = sq;
            }
        __syncthreads();
        float* X = (float*)(ws + WS_X) + ((size_t)(PH * 258 + u.pm) * 4) * 256;
        if (tid < 256) __hip_atomic_store(X + u.pn * 256 + tid, lpart[tid] + lpart[256 + tid] + lpart[512 + tid] + lpart[768 + tid], __ATOMIC_RELAXED, __HIP_MEMORY_SCOPE_AGENT);
        asm volatile("s_waitcnt vmcnt(0)" ::: "memory");
        __syncthreads();
        if (tid == 0) { unsigned* cnt = (unsigned*)(ws + WS_CTL) + CW_PANEL + PH * CW_PANEL_STRIDE + u.pm; (void)cw_add(cnt, 1u);
            unsigned sp = 0; while (cw_ld(cnt) < 4u) { __builtin_amdgcn_s_sleep(1); if (++sp > (1u << 24)) break; } }
        __syncthreads();
        if (tid < 256) { float tot = 0.f;
#pragma unroll
            for (int q = 0; q < 4; ++q) tot += __hip_atomic_load(X + q * 256 + tid, __ATOMIC_RELAXED, __HIP_MEMORY_SCOPE_AGENT);
            lrs[tid] = alpha * __builtin_amdgcn_rsqf(tot * (1.f / D) + EPS); }
        __syncthreads();
        f32x4 g[2][2];
#pragma unroll
        for (int bj = 0; bj < 2; ++bj) { g[bj][0] = *(const f32x4*)(gpost + col0 + bj * HALF); g[bj][1] = *(const f32x4*)(gpost + col0 + bj * HALF + 4); }
#pragma unroll
        for (int ai = 0; ai < 2; ++ai)
#pragma unroll
            for (int m = 0; m < 4; ++m) {
                const int rloc = rloc0 + ai * HALF + m * 16; const float rs = lrs[rloc];
                const size_t ro = (size_t)(u.pm * BM + rloc) * D + col0;
                float sq = 0.f;
#pragma unroll
                for (int bj = 0; bj < 2; ++bj) {
                    f32x4 h0, h1; unpack8(*(const u32x4*)(hin + ro + bj * HALF), h0, h1);
                    h0 = h0 + acc[ai][bj][m][0] * g[bj][0] * rs; h1 = h1 + acc[ai][bj][m][1] * g[bj][1] * rs;
                    if (PH < 2) { const u32x4 w = pack8(h0, h1); *(u32x4*)((bf16_t*)out + ro + bj * HALF) = w; f32x4 r0, r1; unpack8(w, r0, r1);
#pragma unroll
                        for (int i = 0; i < 4; ++i) sq += r0[i] * r0[i] + r1[i] * r1[i]; }
                    if (PH == 2) *(u32x4*)((bf16_t*)(ws + WS_AN) + ro + bj * HALF) = pack8(h0, h1);
                    if (PH == 3) { *(f32x4*)(out + ro + bj * HALF) = h0; *(f32x4*)(out + ro + bj * HALF + 4) = h1; }
                }
                if (PH < 2) { sq += __shfl_xor(sq, 16); sq += __shfl_xor(sq, 32); if (fq == 0) lpart[wc * 256 + rloc] = sq; }
            }
        if (PH < 2) {
            __syncthreads();
            if (tid < 256) (void)__hip_atomic_fetch_add((float*)(ws + WS_SS) + (size_t)PH * MT + u.pm * BM + tid, lpart[tid] + lpart[256 + tid] + lpart[512 + tid] + lpart[768 + tid], __ATOMIC_RELAXED, __HIP_MEMORY_SCOPE_AGENT);
        }
        __syncthreads();
    }
};
template <int PH> __device__ __forceinline__ NormP fused_normp(unsigned char* ws, float* out, const float* ng) {
    bf16_t* Fb = (bf16_t*)(ws + WS_F); bf16_t* HBb = (bf16_t*)out; bf16_t* ANb = (bf16_t*)(ws + WS_AN); float* FSb = (float*)(ws + WS_FS); float* RSb = (float*)(ws + WS_RS);
    if (PH == 0) return NormP{Fb, FSb, 11, HBb, HBb, nullptr, ng + 1 * D, 0.5f, RSb + 1 * MT, nullptr};
    if (PH == 1) return NormP{Fb, FSb, 4, HBb, HBb, nullptr, ng + 3 * D, 1.f, RSb + 2 * MT, nullptr};
    if (PH == 2) return NormP{Fb, FSb, 11, HBb, nullptr, nullptr, ng + 5 * D, 0.5f, nullptr, ANb};
    return NormP{Fb, FSb, 4, ANb, nullptr, out, ng + 6 * D, 1.f, nullptr, nullptr};
}
template <int OUTH, int ANM, bool PLE = false>
__device__ __forceinline__ void sample_norm(const Args& a, const NormP& p, unsigned* cnt, int nitems) {
    const int G = gridDim.x, lane = threadIdx.x & 63, wv = threadIdx.x >> 6;
    arrive_and_wait(cnt, (unsigned)nitems, (int)blockIdx.x < nitems, (int)blockIdx.x * 8 < MS);
    for (int r = MP + blockIdx.x * 8 + wv; r < MT; r += G * 8) {
        f32x4 h[4], f[4];
        norm_load_h<1>(a, p, r, lane, h);
#pragma unroll
        for (int i = 0; i < 4; ++i) { f32x4 v = *(const f32x4*)(p.FS + (size_t)(r - MP) * D + 256 * i + 4 * lane);
            for (int k = 1; k < p.nsplit; ++k) v = v + *(const f32x4*)(p.FS + ((size_t)k * MS + (r - MP)) * D + 256 * i + 4 * lane);
            if (PLE) { const u32x2 w = *(const u32x2*)(p.F + (size_t)r * D + 256 * i + 4 * lane);
                v[0] = sigmoidf_(v[0]) * bf_lo(w.x); v[1] = sigmoidf_(v[1]) * bf_hi(w.x); v[2] = sigmoidf_(v[2]) * bf_lo(w.y); v[3] = sigmoidf_(v[3]) * bf_hi(w.y); }
            f[i] = v; }
        norm_finish<true, OUTH, ANM>(p, r, lane, h, f);
    }
}

__device__ __forceinline__ float max3f(float a, float b, float c) { float r; asm("v_max3_f32 %0, %1, %2, %3" : "=v"(r) : "v"(a), "v"(b), "v"(c)); return r; }
constexpr float LOG2E = 1.4426950408889634f;
constexpr int AT_KS = 0, AT_VS = 9216, AT_BUF = 18432, AT_TB = 2 * 18432, AT_ROW = 144;
__device__ __forceinline__ int crow(int r, int hi) { return (r & 3) + 8 * (r >> 2) + 4 * hi; }

__device__ __forceinline__ void attn_unit(LAS unsigned char* lds, const bf16_t* qb, bf16_t* ob, const bf16_t* kbase, const bf16_t* vbase, int vpitch,
                                          const float* tb_g, int c0, int nq, bool samp) {
    const int tid = threadIdx.x, lane = tid & 63, w = __builtin_amdgcn_readfirstlane(tid >> 6), l32 = lane & 31, hi = lane >> 5;
    const int cw = c0 + (w >> 1), half = w & 1;
    const bool wact = (w >> 1) < nq && (!samp || w == 0);
    LAS float* tb = (LAS float*)(lds + AT_TB);
    __syncthreads();
    if (tid < 255) { const int d = tid - 63; tb[tid] = (tb_g[(d > 128 ? 128 : d) + 128] - tb_g[256]) * LOG2E; }
    bf16x8 qf[4];
    {
        int qr = (w >> 1) * 64 + half * 32 + l32; if (samp) qr &= 15; if (!wact) qr = 0;
        const bf16_t* qp = qb + (size_t)qr * 512 + 8 * hi;
#pragma unroll
        for (int ks = 0; ks < 4; ++ks) qf[ks] = *(const bf16x8*)(qp + 16 * ks);
    }
    f32x16 o0, o1;
#pragma unroll
    for (int i = 0; i < 16; ++i) { o0[i] = 0.f; o1[i] = 0.f; }
    float mrun = -1e30f, lrun = 0.f;
    const int kc_lo = c0 - 8 < 0 ? 0 : c0 - 8, kc_hi = c0 + nq - 1;
    const int rr = tid >> 3, seg = tid & 7;
    const bf16_t* kg = kbase + (size_t)rr * 512 + seg * 8;
    const bf16_t* vg = vbase + (size_t)rr * vpitch + seg * 8;
    u32x4 kv = *(const u32x4*)(kg + (size_t)(kc_lo * 64) * 512), vv = *(const u32x4*)(vg + kc_lo * 64);
    int buf = 0;
    for (int kc = kc_lo; kc <= kc_hi; ++kc) {
        LAS unsigned char* lb = lds + buf * AT_BUF;
        *(LAS u32x4*)(lb + AT_KS + rr * AT_ROW + seg * 16) = kv;
        *(LAS u32x4*)(lb + AT_VS + rr * AT_ROW + seg * 16) = vv;
        __syncthreads();
        if (kc < kc_hi) { kv = *(const u32x4*)(kg + (size_t)((kc + 1) * 64) * 512); vv = *(const u32x4*)(vg + (kc + 1) * 64); }
        buf ^= 1;
        if (wact && kc >= cw - 8 && kc <= cw) {
            f32x16 s0, s1;
            if (cw - kc >= 3) {
#pragma unroll
                for (int i = 0; i < 16; ++i) { s0[i] = 0.f; s1[i] = 0.f; }
            } else {
                const LAS float* ep = tb + ((cw - kc) * 64 + half * 32 + l32 - 4 * hi + 4);
#pragma unroll
                for (int i = 0; i < 16; ++i) { s0[i] = ep[59 - ((i & 3) + 8 * (i >> 2))]; s1[i] = ep[27 - ((i & 3) + 8 * (i >> 2))]; }
            }
#pragma unroll
            for (int ks = 0; ks < 4; ++ks) {
                const bf16x8 ka = *(const LAS bf16x8*)(lb + AT_KS + l32 * AT_ROW + ks * 32 + hi * 16);
                const bf16x8 kb = *(const LAS bf16x8*)(lb + AT_KS + (32 + l32) * AT_ROW + ks * 32 + hi * 16);
                s0 = __builtin_amdgcn_mfma_f32_32x32x16_bf16(ka, qf[ks], s0, 0, 0, 0);
                s1 = __builtin_amdgcn_mfma_f32_32x32x16_bf16(kb, qf[ks], s1, 0, 0, 0);
            }
            if (samp && kc == 8) {
#pragma unroll
                for (int i = 0; i < 16; ++i) { if (i >= 8) s0[i] = -1e30f; s1[i] = -1e30f; } }
            float mx = max3f(s0[0], s0[1], s1[0]);
            mx = max3f(mx, s1[1], s0[2]);
#pragma unroll
            for (int i = 3; i < 16; i += 2) { mx = max3f(mx, s0[i], s0[i < 15 ? i + 1 : i]); }
#pragma unroll
            for (int i = 2; i < 16; i += 2) { mx = max3f(mx, s1[i], s1[i + 1]); }
            mx = fmaxf(mx, __shfl_xor(mx, 32));
            const float mn = fmaxf(mrun, mx);
            if (__builtin_amdgcn_ballot_w64(mn > mrun) != 0) {
                const float alpha = __builtin_amdgcn_exp2f(mrun - mn);
                lrun *= alpha; mrun = mn;
#pragma unroll
                for (int i = 0; i < 16; ++i) { o0[i] *= alpha; o1[i] *= alpha; }
            }
            float rs = 0.f;
#pragma unroll
            for (int i = 0; i < 16; ++i) { s0[i] = __builtin_amdgcn_exp2f(s0[i] - mn); s1[i] = __builtin_amdgcn_exp2f(s1[i] - mn); rs += s0[i] + s1[i]; }
            rs += __shfl_xor(rs, 32);
            lrun += rs;
            bf16x8 pf[4];
#pragma unroll
            for (int kb2 = 0; kb2 < 2; ++kb2) {
                u32x4 a, b;
                a.x = cvt_pk_bf16(s0[8 * kb2 + 0], s0[8 * kb2 + 1]); a.y = cvt_pk_bf16(s0[8 * kb2 + 2], s0[8 * kb2 + 3]); a.z = cvt_pk_bf16(s0[8 * kb2 + 4], s0[8 * kb2 + 5]); a.w = cvt_pk_bf16(s0[8 * kb2 + 6], s0[8 * kb2 + 7]);
                b.x = cvt_pk_bf16(s1[8 * kb2 + 0], s1[8 * kb2 + 1]); b.y = cvt_pk_bf16(s1[8 * kb2 + 2], s1[8 * kb2 + 3]); b.z = cvt_pk_bf16(s1[8 * kb2 + 4], s1[8 * kb2 + 5]); b.w = cvt_pk_bf16(s1[8 * kb2 + 6], s1[8 * kb2 + 7]);
                pf[kb2] = __builtin_bit_cast(bf16x8, a); pf[2 + kb2] = __builtin_bit_cast(bf16x8, b);
            }
#pragma unroll
            for (int kt = 0; kt < 4; ++kt) {
                const s16x4 a0 = *(const LAS s16x4*)(lb + AT_VS + l32 * AT_ROW + (16 * kt + 4 * hi) * 2), a1 = *(const LAS s16x4*)(lb + AT_VS + l32 * AT_ROW + (16 * kt + 4 * hi) * 2 + 16);
                const s16x4 b0 = *(const LAS s16x4*)(lb + AT_VS + (32 + l32) * AT_ROW + (16 * kt + 4 * hi) * 2), b1 = *(const LAS s16x4*)(lb + AT_VS + (32 + l32) * AT_ROW + (16 * kt + 4 * hi) * 2 + 16);
                const bf16x8 va = (bf16x8){a0[0], a0[1], a0[2], a0[3], a1[0], a1[1], a1[2], a1[3]}, vb = (bf16x8){b0[0], b0[1], b0[2], b0[3], b1[0], b1[1], b1[2], b1[3]};
                o0 = __builtin_amdgcn_mfma_f32_32x32x16_bf16(va, pf[kt], o0, 0, 0, 0);
                o1 = __builtin_amdgcn_mfma_f32_32x32x16_bf16(vb, pf[kt], o1, 0, 0, 0);
            }
        }
    }
    if (wact) {
        const int qr = (w >> 1) * 64 + half * 32 + l32;
        if (!samp || qr < 16) {
            const float inv = 1.f / lrun;
            bf16_t* op = ob + (size_t)qr * 512 + 4 * hi;
#pragma unroll
            for (int g = 0; g < 4; ++g) {
                u32x2 x, y;
                x.x = cvt_pk_bf16(o0[4 * g] * inv, o0[4 * g + 1] * inv); x.y = cvt_pk_bf16(o0[4 * g + 2] * inv, o0[4 * g + 3] * inv);
                y.x = cvt_pk_bf16(o1[4 * g] * inv, o1[4 * g + 1] * inv); y.y = cvt_pk_bf16(o1[4 * g + 2] * inv, o1[4 * g + 3] * inv);
                *(u32x2*)(op + 8 * g) = x; *(u32x2*)(op + 32 + 8 * g) = y;
            }
        }
    }
}

#define XB_TMO      128
#define XB_XCNT(j)  (256  + 64 * (j))
#define XB_XSUB(j)  (1280 + 64 * (j))
#define XB_XGEN(j)  (2304 + 64 * (j))
#define XB_TOP      3328
#define XB_TOPGEN   3392
#define XCD_BAR_WORDS 3456
#define XB_SPIN_CAP (1u << 22)
__device__ __forceinline__ unsigned xb_ld(unsigned* p)              { return __hip_atomic_load(p, __ATOMIC_RELAXED, __HIP_MEMORY_SCOPE_AGENT); }
__device__ __forceinline__ unsigned xb_add(unsigned* p, unsigned v) { return __hip_atomic_fetch_add(p, v, __ATOMIC_RELAXED, __HIP_MEMORY_SCOPE_AGENT); }
__device__ __forceinline__ unsigned xb_xcc_id() { return (unsigned)__builtin_amdgcn_s_getreg((3 << 11) | 20) & 0xFu; }
#define XB_SPIN(cond, bar) do { unsigned _sp = 0; while (cond) { __builtin_amdgcn_s_sleep(1); \
    if ((++_sp & 255u) == 0u) { if (xb_ld(&(bar)[XB_TMO])) break; if (_sp > XB_SPIN_CAP) { atomicAdd(&(bar)[XB_TMO], 1u); break; } } } } while (0)
struct XcdBarrier { unsigned* bar; unsigned x; volatile LAS unsigned* st; };
__device__ __forceinline__ XcdBarrier xcd_barrier_post(unsigned* bar, volatile LAS unsigned* st) {
    XcdBarrier b; b.bar = bar; b.x = xb_xcc_id(); b.st = st;
    if (threadIdx.x == 0) (void)xb_add(&bar[XB_XCNT(b.x)], 1u);
    return b;
}
__device__ __forceinline__ void xcd_barrier_complete(unsigned* bar, unsigned x, unsigned& nloc, unsigned& nx) {
    const unsigned G = gridDim.x * gridDim.y * gridDim.z;
    unsigned sum, cnt, mine, sp = 0u;
    for (;;) {
        sum = 0u; cnt = 0u; mine = 0u;
#pragma unroll
        for (unsigned j = 0; j < 16; ++j) { const unsigned c = xb_ld(&bar[XB_XCNT(j)]); sum += c; cnt += (c > 0u) ? 1u : 0u; mine = (j == x) ? c : mine; }
        if (sum == G) break;
        __builtin_amdgcn_s_sleep(1);
        if ((++sp & 255u) == 0u) { if (xb_ld(&bar[XB_TMO])) break; if (sp > XB_SPIN_CAP) { atomicAdd(&bar[XB_TMO], 1u); break; } }
    }
    nloc = mine > 0u ? mine : 1u; nx = cnt > 0u ? cnt : 1u;
}
__device__ __forceinline__ void xcd_barrier(const XcdBarrier& b) {
    asm volatile("s_waitcnt vmcnt(0)" ::: "memory");
    __syncthreads();
    if (threadIdx.x == 0) {
        unsigned* bar = b.bar;
        __builtin_amdgcn_s_waitcnt(0);
        unsigned nloc = b.st[0], nx = b.st[1];
        if (nloc == 0u) { xcd_barrier_complete(bar, b.x, nloc, nx); b.st[0] = nloc; b.st[1] = nx; }
        const unsigned old = xb_add(&bar[XB_XSUB(b.x)], 1u);
        const unsigned gen = old / nloc;
        if (old + 1u == (gen + 1u) * nloc) {
            __builtin_amdgcn_fence(__ATOMIC_RELEASE, "agent");
            asm volatile("s_waitcnt vmcnt(0)" ::: "memory");
            const unsigned og = xb_add(&bar[XB_TOP], 1u);
            const unsigned tg = og / nx;
            if (og + 1u == (tg + 1u) * nx) xb_add(&bar[XB_TOPGEN], 1u);
            else XB_SPIN(xb_ld(&bar[XB_TOPGEN]) == tg, bar);
            __builtin_amdgcn_fence(__ATOMIC_ACQUIRE, "agent");
            xb_add(&bar[XB_XGEN(b.x)], 1u);
            asm volatile("s_waitcnt vmcnt(0)" ::: "memory");
        } else {
            XB_SPIN(xb_ld(&bar[XB_XGEN(b.x)]) == gen, bar);
            __builtin_amdgcn_fence(__ATOMIC_ACQUIRE, "agent");
            asm volatile("s_waitcnt vmcnt(0)" ::: "memory");
        }
    }
    __syncthreads();
}

__global__ void __launch_bounds__(512, 2) fwd_kernel(Args a) {
    extern __shared__ __attribute__((aligned(16))) unsigned char lds_raw[];
    LAS unsigned char* lds = (LAS unsigned char*)lds_raw;
    cg::grid_group grid = cg::this_grid();
    const int lo = a.ph_lo, hi = a.ph_hi, G = gridDim.x, tid = threadIdx.x;
    volatile LAS unsigned* bst = (volatile LAS unsigned*)(lds + 131072 + 1008);
    if (tid == 0) { bst[0] = 0u; bst[1] = 0u; }
    __syncthreads();
    XcdBarrier xbar = xcd_barrier_post((unsigned*)(a.ws + WS_CTL), bst);
    unsigned char* ws = a.ws;
    bf16_t* W1GU = (bf16_t*)(ws + WS_W1GU); bf16_t* W1D = (bf16_t*)(ws + WS_W1D); bf16_t* WIN = (bf16_t*)(ws + WS_WIN); bf16_t* WAO = (bf16_t*)(ws + WS_WAO);
    bf16_t* WCO = (bf16_t*)(ws + WS_WCO); bf16_t* WOUT = (bf16_t*)(ws + WS_WOUT); bf16_t* W2GU = (bf16_t*)(ws + WS_W2GU); bf16_t* W2D = (bf16_t*)(ws + WS_W2D);
    bf16_t* WPG = (bf16_t*)(ws + WS_WPG); bf16_t* WPP = (bf16_t*)(ws + WS_WPP); bf16_t* PB = (bf16_t*)(ws + WS_PB); bf16_t* AN = (bf16_t*)(ws + WS_AN);
    bf16_t* F = (bf16_t*)(ws + WS_F); bf16_t* ACT = (bf16_t*)(ws + WS_ACT); bf16_t* Qb = (bf16_t*)(ws + WS_Q); bf16_t* Kb = (bf16_t*)(ws + WS_K);
    bf16_t* Vt = (bf16_t*)(ws + WS_VT); bf16_t* Vts = (bf16_t*)(ws + WS_VTS); bf16_t* Sb = (bf16_t*)(ws + WS_S); bf16_t* Bg = (bf16_t*)(ws + WS_BG);
    bf16_t* SA = (bf16_t*)(ws + WS_SA); bf16_t* SC = (bf16_t*)(ws + WS_SC); bf16_t* MM = (bf16_t*)(ws + WS_MM); bf16_t* ATT = (bf16_t*)(ws + WS_ATT); bf16_t* YC = (bf16_t*)(ws + WS_YC);
    float* H = a.out + O_Y;
    float* FSP = (float*)(ws + WS_FS);
    float* RS = (float*)(ws + WS_RS);
    unsigned* CW = (unsigned*)(ws + WS_CTL);
    bf16_t* HB = (bf16_t*)(a.out + O_Y);
    const float* ng = a.in[I_NG];
#define IN(k) (lo <= (k) && (k) < hi)
#define SEAM(k) do { if (IN(k) && IN((k) + 1)) xcd_barrier(xbar); } while (0)
    if (lo < 0) grid.sync();

    auto ident = [](int cb, int& c0, int& r0) { c0 = 64 * cb; r0 = 64 * cb; };
    auto gate = [](int cb, int& c0, int& r0) { c0 = 64 * cb; r0 = 256 * (cb >> 1) + 64 * (cb & 1); };
    auto up = [](int cb, int& c0, int& r0) { c0 = 64 * cb; r0 = 256 * (cb >> 1) + 128 + 64 * (cb & 1); };
    auto winmap = [](int db, int& c0, int& r0) { r0 = 64 * db; const int pn = db >> 2, q = db & 3;
        if (pn < 6) c0 = 256 * pn + 64 * q; else if (pn < 10) c0 = (q < 2 ? 1536 : 2560) + 128 * (pn - 6) + 64 * (q & 1); else if (pn < 12) c0 = 2048 + 256 * (pn - 10) + 64 * q; else c0 = 3072 + 256 * (pn - 12) + 64 * q; };
    if (IN(0)) {
        LAS float* t = (LAS float*)lds;
        int job = 0;
        tr_matrix(t, job, G, (int)blockIdx.x, a.in[I_W1G], FF, D, FF / 64, W1GU, D, gate, ng + 0 * D);
        tr_matrix(t, job, G, (int)blockIdx.x, a.in[I_W1U], FF, D, FF / 64, W1GU, D, up, ng + 0 * D);
        norm_rows<0, false, 1, 1>(a, NormP{nullptr, nullptr, 0, nullptr, HB, nullptr, nullptr, 0.f, RS + 0 * MT, nullptr});
    }
    SEAM(0);
    if (IN(1)) { pg8::Gemm g{HB, W1GU, D, D}; pg8::StaticOrder S; S.init(MT, 2 * FF, G, blockIdx.x); pg8::EpiGateUp E{ACT, RS + 0 * MT, nullptr}; pg8::gemm_phase(lds, g, S, E);
        constexpr int NB = (MT / 256) * (2 * FF / 256) % 256;
        const int me = (int)blockIdx.x - NB, nw = G - NB;
        if (me >= 0) { LAS float* t = (LAS float*)lds; int job = 0;
            tr_matrix(t, job, nw, me, a.in[I_W1D], D, FF, D / 64, W1D, FF, ident);
            tr_matrix(t, job, nw, me, a.in[I_WIN], DIN, D, DIN / 64, WIN, D, winmap, ng + 2 * D);
            tr_matrix(t, job, nw, me, a.in[I_WAO], D, DA, D / 64, WAO, DA, ident);
            tr_matrix(t, job, nw, me, a.in[I_WCO], D, DA, D / 64, WCO, DA, ident);
            tr_matrix(t, job, nw, me, a.in[I_WOUT], D, D, D / 64, WOUT, D, ident); } }
    SEAM(1);
    if (IN(2)) {
        { pg8::Gemm g{ACT, W1D, FF, FF}; pg8::StaticOrder S; S.init(MP, D, G, blockIdx.x);
          EpiX<0> E{ws, a.out, ng, lds}; pg8::gemm_phase(lds, g, S, E); }
        { const int id = blockIdx.x, ks = id % 11, t = id / 11;
          pg8::Gemm g2{ACT + ks * (FF / 11), W1D + ks * (FF / 11), FF / 11, FF}; pg8::OneUnit S2{MP / 256 + (t >> 2), t & 3, id < 8 * 11}; pg8::EpiPartial E2{FSP + (size_t)ks * MS * D}; pg8::gemm_phase(lds, g2, S2, E2); }
        sample_norm<1, 1>(a, fused_normp<0>(ws, a.out, ng), CW + CW_SAMPLE + 0, 8 * 11);
    }
    SEAM(2);
    if (IN(4)) { pg8::Gemm g{HB, WIN, D, D}; pg8::StaticOrder S; S.init(MT, DIN, G, blockIdx.x); pg8::EpiWin E{Qb, Kb, Vt, Vts, Sb, Bg, SA, SC, a.out, RS + 1 * MT, (const float*)(ws + WS_SS) + 0 * MT}; pg8::gemm_phase(lds, g, S, E);
        constexpr int NB = (MT / 256) * (DIN / 256) % 256;
        const int me = (int)blockIdx.x - NB, nw = G - NB;
        if (me >= 0) {
            LAS float* t = (LAS float*)lds; int job = 0;
            for (int b = 0; b < SB; ++b)
                tr_matrix(t, job, nw, me, a.in[I_CV] + (size_t)b * 512 * 512, 512, 512, 8, Vts + (size_t)b * 512 * SKV, SKV, ident);
            for (size_t i = (size_t)me * 512 + threadIdx.x; i < (size_t)SB * 512 * 512 / 8; i += (size_t)nw * 512) {
                const size_t e = i * 8; const int b = (int)(e >> 18), rem = (int)(e & 262143);
                const float* src = a.in[I_CK] + e;
                *(u32x4*)(Kb + ((size_t)MP + (size_t)b * SKV) * 512 + rem) = pg8::pack8(*(const f32x4*)src, *(const f32x4*)(src + 4));
            } } }
    SEAM(4);
    if (IN(5)) {
        const float* rb = a.in[I_RB];
        for (int u = blockIdx.x; u < NB * 8 * 32 + SB * 8; u += G) {
            if (u < NB * 8 * 32) { const int j = u & 31, h = (u >> 5) & 7, b = u >> 8;
                attn_unit(lds, Qb + ((size_t)b * SEQ + j * 256) * 512 + h * 64, ATT + ((size_t)b * SEQ + j * 256) * 512 + h * 64, Kb + (size_t)b * SEQ * 512 + h * 64,
                          Vt + ((size_t)b * 512 + h * 64) * SEQ, SEQ, rb + h * 257, 4 * j, 4, false);
            } else { const int us = u - NB * 8 * 32, h = us & 7, b = us >> 3;
                attn_unit(lds, Qb + ((size_t)MP + b * ST) * 512 + h * 64, ATT + ((size_t)MP + b * ST) * 512 + h * 64, Kb + ((size_t)MP + (size_t)b * SKV) * 512 + h * 64,
                          Vts + ((size_t)b * 512 + h * 64) * SKV, SKV, rb + h * 257, 8, 1, true);
            }
        }
        const float* cw = a.in[I_CW]; const float* cc = a.in[I_CC];
        for (size_t i = (size_t)blockIdx.x * 512 + tid; i < (size_t)(MT / 4) * 64; i += (size_t)G * 512) {
            const int r0 = (int)(i >> 6) * 4, c = (int)(i & 63) * 8;
            int t0; const float* pre = nullptr;
            if (r0 < MP) t0 = r0 & 8191; else { const int rs = r0 - MP; t0 = rs & 15; pre = cc + (size_t)(rs >> 4) * 2 * 512; }
            f32x4 sa[6], sb[6], ba[4], bb[4];
#pragma unroll
            for (int k = 0; k < 4; ++k) { pg8::unpack8(*(const u32x4*)(Sb + (size_t)(r0 + k) * 512 + c), sa[k + 2], sb[k + 2]); pg8::unpack8(*(const u32x4*)(Bg + (size_t)(r0 + k) * 512 + c), ba[k], bb[k]); }
            if (t0 != 0) { pg8::unpack8(*(const u32x4*)(Sb + (size_t)(r0 - 2) * 512 + c), sa[0], sb[0]); pg8::unpack8(*(const u32x4*)(Sb + (size_t)(r0 - 1) * 512 + c), sa[1], sb[1]); }
            else if (pre) { sa[0] = *(const f32x4*)(pre + c); sb[0] = *(const f32x4*)(pre + c + 4); sa[1] = *(const f32x4*)(pre + 512 + c); sb[1] = *(const f32x4*)(pre + 512 + c + 4); }
            else { sa[0] = (f32x4){0.f, 0.f, 0.f, 0.f}; sb[0] = sa[0]; sa[1] = sa[0]; sb[1] = sa[0]; }
            const f32x4 w0a = *(const f32x4*)(cw + c), w0b = *(const f32x4*)(cw + c + 4), w1a = *(const f32x4*)(cw + 512 + c), w1b = *(const f32x4*)(cw + 512 + c + 4),
                        w2a = *(const f32x4*)(cw + 1024 + c), w2b = *(const f32x4*)(cw + 1024 + c + 4);
#pragma unroll
            for (int k = 0; k < 4; ++k) {
                const f32x4 ya = ba[k] * (sa[k] * w0a + sa[k + 1] * w1a + sa[k + 2] * w2a), yb = bb[k] * (sb[k] * w0b + sb[k + 1] * w1b + sb[k + 2] * w2b);
                *(u32x4*)(YC + (size_t)(r0 + k) * 512 + c) = pg8::pack8(ya, yb);
            }
        }
    }
    SEAM(5);
    if (IN(6)) {
        const int id = blockIdx.x, ks = id & 1, ts = id >> 1, me6 = id - 16, nw6 = G - 16;
        { pg8::Gemm g{ATT, WAO, DA, DA}; pg8::StaticOrder S; S.init(MP, D, G, blockIdx.x); pg8::EpiStd<1> E{MM, SA, D}; pg8::gemm_phase(lds, g, S, E); }
        { pg8::Gemm g2{ATT + ks * 256, WAO + ks * 256, 256, DA}; pg8::OneUnit S2{MP / 256 + (ts >> 2), ts & 3, id < 16}; pg8::EpiPartialG E2{FSP + (size_t)ks * MS * D, SA}; pg8::gemm_phase(lds, g2, S2, E2); }
        if (me6 >= 0) { LAS float* t = (LAS float*)lds; int job = 0;
            tr_matrix(t, job, nw6, me6, a.in[I_W2G], FF, D, FF / 64, W2GU, D, gate, ng + 4 * D);
            tr_matrix(t, job, nw6, me6, a.in[I_W2U], FF, D, FF / 64, W2GU, D, up, ng + 4 * D); }
        { pg8::Gemm g{YC, WCO, DA, DA}; pg8::StaticOrder S; S.init(MP, D, G, blockIdx.x); pg8::EpiStd<2> E{MM, SC, D}; pg8::gemm_phase(lds, g, S, E); }
        { pg8::Gemm g2{YC + ks * 256, WCO + ks * 256, 256, DA}; pg8::OneUnit S2{MP / 256 + (ts >> 2), ts & 3, id < 16}; pg8::EpiPartialG E2{FSP + (size_t)(2 + ks) * MS * D, SC}; pg8::gemm_phase(lds, g2, S2, E2); }
        if (me6 >= 0) { LAS float* t = (LAS float*)lds; int job = 0; tr_matrix(t, job, nw6, me6, a.in[I_W2D], D, FF, D / 64, W2D, FF, ident); }
        arrive_and_wait(CW + CW_SAMPLE + 4, 16u, id < 16, id * 8 < MS);
        { const int tn = tid_now(), lane = tn & 63, wv = tn >> 6;
          for (int r = id * 8 + wv; r < MS; r += G * 8) {
#pragma unroll
              for (int i = 0; i < 4; ++i) { const size_t o = (size_t)r * D + 256 * i + 4 * lane;
                  const f32x4 v = *(const f32x4*)(FSP + o) + *(const f32x4*)(FSP + (size_t)MS * D + o) + *(const f32x4*)(FSP + (size_t)2 * MS * D + o) + *(const f32x4*)(FSP + (size_t)3 * MS * D + o);
                  u32x2 w; w.x = cvt_pk_bf16(v[0], v[1]); w.y = cvt_pk_bf16(v[2], v[3]); *(u32x2*)(MM + (size_t)(MP + r) * D + 256 * i + 4 * lane) = w; } } }
    }
    SEAM(6);
    if (IN(7)) {
        { pg8::Gemm g{MM, WOUT, D, D}; pg8::StaticOrder S; S.init(MP, D, G, blockIdx.x);
          EpiX<1> E{ws, a.out, ng, lds}; pg8::gemm_phase(lds, g, S, E); }
        { const int id = blockIdx.x, ks = id % 4, t = id / 4;
          pg8::Gemm g2{MM + ks * (D / 4), WOUT + ks * (D / 4), D / 4, D}; pg8::OneUnit S2{MP / 256 + (t >> 2), t & 3, id < 8 * 4}; pg8::EpiPartial E2{FSP + (size_t)ks * MS * D}; pg8::gemm_phase(lds, g2, S2, E2); }
        sample_norm<1, 1>(a, fused_normp<1>(ws, a.out, ng), CW + CW_SAMPLE + 1, 8 * 4);
    }
    SEAM(7);
    if (IN(9)) { pg8::Gemm g{HB, W2GU, D, D}; pg8::StaticOrder S; S.init(MT, 2 * FF, G, blockIdx.x); pg8::EpiGateUp E{ACT, RS + 2 * MT, (const float*)(ws + WS_SS) + 1 * MT}; pg8::gemm_phase(lds, g, S, E);
        constexpr int NB = (MT / 256) * (2 * FF / 256) % 256;
        const int me = (int)blockIdx.x - NB, nw = G - NB;
        if (me >= 0) { LAS float* t = (LAS float*)lds; int job = 0;
            tr_matrix(t, job, nw, me, a.in[I_WPG], D, D, D / 64, WPG, D, ident);
            tr_matrix(t, job, nw, me, a.in[I_WPP], D, DPLE, D / 64, WPP, DPLE, ident);
            for (size_t i = (size_t)me * 512 + threadIdx.x; i < (size_t)MT * DPLE / 8; i += (size_t)nw * 512) {
                const size_t e = i * 8; const float* src = e < (size_t)MP * DPLE ? a.in[I_PP] + e : a.in[I_PS] + (e - (size_t)MP * DPLE);
                *(u32x4*)(PB + e) = pg8::pack8(*(const f32x4*)src, *(const f32x4*)(src + 4));
            } } }
    SEAM(9);
    if (IN(10)) {
        { pg8::Gemm g{ACT, W2D, FF, FF}; pg8::StaticOrder S; S.init(MP, D, G, blockIdx.x);
          EpiX<2> E{ws, a.out, ng, lds}; pg8::gemm_phase(lds, g, S, E); }
        { const int id = blockIdx.x, ks = id % 11, t = id / 11;
          pg8::Gemm g2{ACT + ks * (FF / 11), W2D + ks * (FF / 11), FF / 11, FF}; pg8::OneUnit S2{MP / 256 + (t >> 2), t & 3, id < 8 * 11}; pg8::EpiPartial E2{FSP + (size_t)ks * MS * D}; pg8::gemm_phase(lds, g2, S2, E2); }
        sample_norm<0, 2>(a, fused_normp<2>(ws, a.out, ng), CW + CW_SAMPLE + 2, 8 * 11);
    }
    SEAM(10);
    if (IN(12)) {
        const int id = blockIdx.x;
        { pg8::Gemm g{PB, WPP, DPLE, DPLE}; pg8::StaticOrder S; S.init(MP, D, G, blockIdx.x); pg8::EpiStd<0> E{F, nullptr, D}; pg8::gemm_phase(lds, g, S, E);
          pg8::OneUnit S2{MP / 256 + (id >> 2), id & 3, id < 8}; pg8::gemm_phase(lds, g, S2, E); }
        { pg8::Gemm g{AN, WPG, D, D}; pg8::StaticOrder S; S.init(MP, D, G, blockIdx.x);
          EpiX<3> E{ws, a.out, ng, lds}; pg8::gemm_phase(lds, g, S, E); }
        { const int ks = id % 4, t = id / 4;
          pg8::Gemm g2{AN + ks * (D / 4), WPG + ks * (D / 4), D / 4, D}; pg8::OneUnit S2{MP / 256 + (t >> 2), t & 3, id < 8 * 4}; pg8::EpiPartial E2{FSP + (size_t)ks * MS * D}; pg8::gemm_phase(lds, g2, S2, E2); }
        sample_norm<2, 0, true>(a, fused_normp<3>(ws, a.out, ng), CW + CW_SAMPLE + 3, 8 * 4);
    }
#undef IN
#undef SEAM
}

constexpr int N_PHASES = 14;
#ifndef ONE_LAUNCH
#define ONE_LAUNCH 1
#endif
extern "C" void kernel_launch(void* const* d_in, const int* in_sizes, int n_in, void* d_out, int out_size, void* d_ws, size_t ws_size, hipStream_t stream) {
    static int grid = 0;
    if (grid == 0) {
        if (n_in != 22 || (size_t)out_size != O_END || ws_size < WS_TOTAL) { fprintf(stderr, "kernel_launch: unexpected shapes (n_in %d out %d ws %zu need %zu)\n", n_in, out_size, ws_size, (size_t)WS_END); grid = -1; return; }
        int dev = 0, cus = 0, per_cu = 0;
        (void)hipGetDevice(&dev); (void)hipDeviceGetAttribute(&cus, hipDeviceAttributeMultiprocessorCount, dev);
        if (hipFuncSetAttribute((const void*)fwd_kernel, hipFuncAttributeMaxDynamicSharedMemorySize, LDS_BYTES) != hipSuccess) { fprintf(stderr, "kernel_launch: hipFuncSetAttribute failed\n"); grid = -1; return; }
        if (hipOccupancyMaxActiveBlocksPerMultiprocessor(&per_cu, (const void*)fwd_kernel, 512, LDS_BYTES) != hipSuccess || per_cu < 1) { fprintf(stderr, "kernel_launch: occupancy query gave %d\n", per_cu); per_cu = 1; }
        (void)hipGetLastError();
        grid = cus * per_cu;
    }
    if (grid < 0) return;
    Args a{};
    for (int i = 0; i < 22; ++i) a.in[i] = (const float*)d_in[i];
    a.out = (float*)d_out; a.ws = (unsigned char*)d_ws;
#if ONE_LAUNCH
    if (hipMemsetAsync((char*)d_ws + WS_CTL, 0, CTL_BYTES, stream) != hipSuccess) { fprintf(stderr, "kernel_launch: memset of the barrier words failed\n"); return; }
    a.ph_lo = 0; a.ph_hi = N_PHASES;
    void* args[] = {&a};
    hipError_t e = hipLaunchCooperativeKernel((const void*)fwd_kernel, dim3(grid), dim3(512), args, LDS_BYTES, stream);
    if (e != hipSuccess) fprintf(stderr, "cooperative launch failed: %s (grid %d)\n", hipGetErrorString(e), grid);
#else
    for (int p = 0; p < N_PHASES; ++p) { a.ph_lo = p; a.ph_hi = p + 1; hipLaunchKernelGGL(fwd_kernel, dim3(grid), dim3(512), LDS_BYTES, stream, a); }
#endif
}
```

```cpp
#include <hip/hip_runtime.h>
#include <hip/hip_cooperative_groups.h>
#include <cstdio>
#include <cstdint>
namespace cg = cooperative_groups;

#define LAS __attribute__((address_space(3)))
typedef unsigned short bf16_t;
typedef short bf16x8 __attribute__((ext_vector_type(8)));
typedef short s16x4 __attribute__((ext_vector_type(4)));
typedef float f32x4 __attribute__((ext_vector_type(4)));
typedef float f32x16 __attribute__((ext_vector_type(16)));
typedef unsigned u32x4 __attribute__((ext_vector_type(4)));
typedef unsigned u32x2 __attribute__((ext_vector_type(2)));

constexpr int MP = 65536, MS = 512, MT = MP + MS;
constexpr int D = 1024, FF = 2816, DIN = 5120, DA = 512, DPLE = 256;
constexpr int SEQ = 8192, NB = 8, SB = 32, ST = 16, SKV = 576;
constexpr int KROWS = MP + SB * SKV;
constexpr float EPS = 1e-6f;

constexpr size_t O_Y = 0;
constexpr size_t O_KP = (size_t)MT * D;
constexpr size_t O_VP = O_KP + (size_t)NB * 512 * 512;
constexpr size_t O_CP = O_VP + (size_t)NB * 512 * 512;
constexpr size_t O_KS = O_CP + (size_t)NB * 2 * 512;
constexpr size_t O_VS = O_KS + (size_t)SB * ST * 512;
constexpr size_t O_CS = O_VS + (size_t)SB * ST * 512;
constexpr size_t O_END = O_CS + (size_t)SB * 2 * 512;

constexpr size_t WS_W1GU = 0;
constexpr size_t WS_W1D  = WS_W1GU + (size_t)2 * FF * D * 2;
constexpr size_t WS_WIN  = WS_W1D + (size_t)D * FF * 2;
constexpr size_t WS_WAO  = WS_WIN + (size_t)DIN * D * 2;
constexpr size_t WS_WCO  = WS_WAO + (size_t)D * DA * 2;
constexpr size_t WS_WOUT = WS_WCO + (size_t)D * DA * 2;
constexpr size_t WS_W2GU = WS_WOUT + (size_t)D * D * 2;
constexpr size_t WS_W2D  = WS_W2GU + (size_t)2 * FF * D * 2;
constexpr size_t WS_WPG  = WS_W2D + (size_t)D * FF * 2;
constexpr size_t WS_WPP  = WS_WPG + (size_t)D * D * 2;
constexpr size_t WS_PB   = WS_WPP + (size_t)D * DPLE * 2;
constexpr size_t WS_AN   = WS_PB + (size_t)MT * DPLE * 2;
constexpr size_t WS_F    = WS_AN + (size_t)MT * D * 2;
constexpr size_t WS_BIG  = WS_F + (size_t)MT * D * 2;
constexpr size_t WS_ACT  = WS_BIG;
constexpr size_t WS_Q    = WS_BIG;
constexpr size_t WS_K    = WS_Q + (size_t)MT * 512 * 2;
constexpr size_t WS_VT   = WS_K + (size_t)KROWS * 512 * 2;
constexpr size_t WS_VTS  = WS_VT + (size_t)NB * 512 * SEQ * 2;
constexpr size_t WS_S    = WS_VTS + (size_t)SB * 512 * SKV * 2;
constexpr size_t WS_BG   = WS_S + (size_t)MT * 512 * 2;
constexpr size_t WS_SA   = WS_BG + (size_t)MT * 512 * 2;
constexpr size_t WS_SC   = WS_SA + (size_t)MT * D * 2;
constexpr size_t WS_END  = WS_SC + (size_t)MT * D * 2;
constexpr size_t WS_MM   = WS_Q;
constexpr size_t WS_ATT  = WS_F;
constexpr size_t WS_YC   = WS_F + (size_t)MT * 512 * 2;
static_assert(WS_ACT + (size_t)MT * FF * 2 <= WS_END, "act overlay");
static_assert(WS_MM + (size_t)MT * D * 2 <= WS_S, "mm overlay");
constexpr size_t WS_CTL = WS_END, CTL_WORDS_BYTES = 32768, SS_BYTES = (size_t)2 * MT * 4, CTL_BYTES = CTL_WORDS_BYTES + SS_BYTES;
constexpr size_t WS_SS = WS_CTL + CTL_WORDS_BYTES;
constexpr size_t WS_FS = WS_CTL + CTL_BYTES, FS_ONE = (size_t)MS * D * 4;
constexpr size_t WS_RS = WS_FS + 11 * FS_ONE;
constexpr size_t WS_X = WS_RS + (size_t)3 * MT * 4;
constexpr size_t WS_TOTAL = WS_X + (size_t)4 * 258 * 4 * 256 * 4;
static_assert(WS_TOTAL <= ((size_t)1 << 30), "workspace");

constexpr int LDS_BYTES = 131072 + 1024 + 4096 + 1024;

__device__ __forceinline__ unsigned cvt_pk_bf16(float lo, float hi) { unsigned r; asm volatile("v_cvt_pk_bf16_f32 %0, %1, %2" : "=v"(r) : "v"(lo), "v"(hi)); return r; }
__device__ __forceinline__ float bf_lo(unsigned u) { return __builtin_bit_cast(float, u << 16); }
__device__ __forceinline__ float bf_hi(unsigned u) { return __builtin_bit_cast(float, u & 0xffff0000u); }
__device__ __forceinline__ float sigmoidf_(float x) { return __builtin_amdgcn_rcpf(1.f + __expf(-x)); }
__device__ __forceinline__ float wave_sum(float v) {
#pragma unroll
    for (int o = 32; o >= 1; o >>= 1) v += __shfl_xor(v, o);
    return v;
}

namespace pg8 {
constexpr int BM = 256, BK = 64, HALF = 128, HTB = HALF * BK * 2, STAGE_BYTES = 8 * HTB, NXCD = 8, WGM = 4;
__host__ __device__ __forceinline__ int lds_byte(int r, int c) { const int st = (r >> 4) * 2 + (c >> 5), rr = r & 15, cc = c & 31, ob = rr * 64 + cc * 2; return st * 1024 + (ob ^ (((ob >> 9) & 1) << 5)); }
__host__ __device__ __forceinline__ void stage_rc(int b, int& R, int& C) { const int st = b / 1024, sb = b % 1024, swz = sb ^ (((sb >> 9) & 1) << 5); R = (st >> 1) * 16 + swz / 64; C = (st & 1) * 32 + (swz % 64) / 2; }
__host__ __device__ __forceinline__ int perm32(int rho) { const int n = rho >> 4, i = rho & 15; return 8 * (i >> 2) + 4 * n + (i & 3); }

struct Unit { int pm, pn; };
struct Gemm { const bf16_t* A; const bf16_t* Bt; int K, ld; };

struct StaticOrder {
    int nM, nN, nwg, G, c;
    __host__ __device__ void init(int M, int N, int G_, int c_) { nM = M / BM; nN = N / BM; nwg = nM * nN; G = G_; c = c_; }
    __host__ __device__ bool next(int i, Unit& u) const {
        const long L = (long)i * G + c; if (L >= nwg) return false;
        int wgid = (int)L; { const int q = nwg / NXCD, r = nwg % NXCD, xcd = wgid % NXCD, off = wgid / NXCD; wgid = (xcd < r ? xcd * (q + 1) : r * (q + 1) + (xcd - r) * q) + off; }
        const int nig = WGM * nN, gid = wgid / nig, fm = gid * WGM, gsz = (nM - fm) < WGM ? (nM - fm) : WGM;
        u.pm = fm + ((wgid % nig) % gsz); u.pn = (wgid % nig) / gsz; return true;
    }
};

template <class Epi, class Sched>
__device__ __forceinline__ void gemm_phase(LAS unsigned char* lds, const Gemm g, const Sched& S, const Epi& E) {
    int tid_ = threadIdx.x; asm volatile("" : "+v"(tid_));
    const int tid = tid_, wid = __builtin_amdgcn_readfirstlane(tid >> 6), lane = tid & 63, wr = wid >> 2, wc = wid & 3, fr = lane & 15, fq = lane >> 4;
    const int K = g.K, ld = g.ld, nt = K / BK;
    unsigned voffA[2], voffB[2];
#pragma unroll
    for (int i = 0; i < 2; ++i) { int R, C; stage_rc(tid * 16 + i * 8192, R, C); const int Rb = (R & ~31) + perm32(R & 31);
        voffA[i] = (unsigned)(R * ld + C) * 2u; voffB[i] = (unsigned)(Rb * ld + C) * 2u; }
    const size_t kstep = (size_t)(BK * 2);
    const size_t hstep = (size_t)HALF * ld * 2;
    const size_t tstep = 2 * hstep;
    const unsigned ldsw = (unsigned)wid * 1024u;
    const int aoff = lds_byte(wr * 64 + fr, fq * 8), boff = lds_byte(wc * 32 + fr, fq * 8);
#define PG8_SA(b, h) (((b) * 2 + (h)) * HTB)
#define PG8_SB(b, h) ((4 + (b) * 2 + (h)) * HTB)
#define PG8_STAGE(bufoff, gbase, voff) do { _Pragma("unroll") for (int _i = 0; _i < 2; ++_i) \
        __builtin_amdgcn_global_load_lds((const unsigned*)((const char*)(gbase) + (voff)[_i]), (LAS unsigned*)(lds + (bufoff) + ldsw + _i * 8192), 16, 0, 0); } while (0)
#define PG8_LDA(dst, b, h) do { _Pragma("unroll") for (int m = 0; m < 4; ++m) _Pragma("unroll") for (int k = 0; k < 2; ++k) dst[m][k] = *(const LAS bf16x8*)(lds + PG8_SA(b, h) + aoff + m * 2048 + k * 1024); } while (0)
#define PG8_LDB(dst, b, h) do { _Pragma("unroll") for (int n = 0; n < 2; ++n) _Pragma("unroll") for (int k = 0; k < 2; ++k) dst[n][k] = *(const LAS bf16x8*)(lds + PG8_SB(b, h) + boff + n * 2048 + k * 1024); } while (0)
#define PG8_MMA(ai, bj, At, Bt) do { __builtin_amdgcn_s_setprio(1); _Pragma("unroll") for (int m = 0; m < 4; ++m) _Pragma("unroll") for (int n = 0; n < 2; ++n) _Pragma("unroll") for (int k = 0; k < 2; ++k) \
        acc[ai][bj][m][n] = __builtin_amdgcn_mfma_f32_16x16x32_bf16(Bt[n][k], At[m][k], acc[ai][bj][m][n], 0, 0, 0); __builtin_amdgcn_s_setprio(0); } while (0)
#define PG8_WAIT_V(n) asm volatile("s_waitcnt vmcnt(" #n ")" ::: "memory")
#define PG8_WAIT_L(n) asm volatile("s_waitcnt lgkmcnt(" #n ")" ::: "memory")
#define PG8_BAR __builtin_amdgcn_s_barrier()
#define PG8_SCHED __builtin_amdgcn_sched_barrier(0)
    Unit cur, nxt; int ui = 0;
    if (!S.next(0, cur)) return;
    f32x4 acc[2][2][4][2];
#pragma unroll
    for (int a = 0; a < 2; ++a)
#pragma unroll
        for (int b = 0; b < 2; ++b)
#pragma unroll
            for (int m = 0; m < 4; ++m)
#pragma unroll
                for (int n = 0; n < 2; ++n) acc[a][b][m][n] = (f32x4){0.f, 0.f, 0.f, 0.f};
    bf16x8 At[4][2], B0[2][2], B1[2][2];
    const char* cA = (const char*)g.A + (size_t)cur.pm * tstep; const char* cB = (const char*)g.Bt + (size_t)cur.pn * tstep;
    PG8_STAGE(PG8_SB(0, 0), cB, voffB); PG8_STAGE(PG8_SB(0, 1), cB + hstep, voffB); PG8_STAGE(PG8_SA(0, 0), cA, voffA); PG8_STAGE(PG8_SA(0, 1), cA + hstep, voffA);
    if (wr == 1) PG8_BAR;
    PG8_WAIT_V(2); PG8_BAR;
    PG8_STAGE(PG8_SB(1, 0), cB + kstep, voffB); PG8_STAGE(PG8_SA(1, 0), cA + kstep, voffA); PG8_STAGE(PG8_SB(1, 1), cB + hstep + kstep, voffB);
    PG8_WAIT_V(6); PG8_BAR;
    for (;;) {
        const bool has_next = S.next(ui + 1, nxt);
        const char* nA = has_next ? (const char*)g.A + (size_t)nxt.pm * tstep : cA; const char* nB = has_next ? (const char*)g.Bt + (size_t)nxt.pn * tstep : cB;
        for (int t = 0; t < nt; t += 2) {
            const bool last = (t == nt - 2);
            const char* a1 = cA + (size_t)(t + 1) * kstep;
            const char* a2 = last ? nA : cA + (size_t)(t + 2) * kstep; const char* b2 = last ? nB : cB + (size_t)(t + 2) * kstep;
            const char* a3 = a2 + kstep; const char* b3 = b2 + kstep;
            PG8_LDB(B0, 0, 0); PG8_LDB(B1, 0, 1); PG8_SCHED; PG8_LDA(At, 0, 0); PG8_STAGE(PG8_SA(1, 1), a1 + hstep, voffA);
            PG8_WAIT_V(8); PG8_WAIT_L(0); PG8_BAR; PG8_MMA(0, 0, At, B0); PG8_MMA(0, 1, At, B1); PG8_BAR; PG8_SCHED;
            PG8_LDA(At, 0, 1); PG8_STAGE(PG8_SB(0, 0), b2, voffB); PG8_STAGE(PG8_SB(0, 1), b2 + hstep, voffB); PG8_STAGE(PG8_SA(0, 0), a2, voffA);
            PG8_WAIT_V(8); PG8_WAIT_L(0); PG8_BAR; PG8_MMA(1, 0, At, B0); PG8_MMA(1, 1, At, B1); PG8_BAR; PG8_SCHED;
            PG8_LDB(B0, 1, 0); PG8_LDB(B1, 1, 1); PG8_SCHED; PG8_LDA(At, 1, 0); PG8_STAGE(PG8_SA(0, 1), a2 + hstep, voffA);
            PG8_WAIT_V(8); PG8_WAIT_L(0); PG8_BAR; PG8_MMA(0, 0, At, B0); PG8_MMA(0, 1, At, B1); PG8_BAR; PG8_SCHED;
            PG8_LDA(At, 1, 1); PG8_STAGE(PG8_SB(1, 0), b3, voffB); PG8_STAGE(PG8_SB(1, 1), b3 + hstep, voffB); PG8_STAGE(PG8_SA(1, 0), a3, voffA);
            PG8_WAIT_V(8); PG8_WAIT_L(0); PG8_BAR; PG8_MMA(1, 0, At, B0); PG8_MMA(1, 1, At, B1); PG8_BAR; PG8_SCHED;
        }
        if (wr == 0) PG8_BAR;
        E(acc, cur, wr, wc, fr, fq);
        if (!has_next) break;
#pragma unroll
        for (int a = 0; a < 2; ++a)
#pragma unroll
            for (int b = 0; b < 2; ++b)
#pragma unroll
                for (int m = 0; m < 4; ++m)
#pragma unroll
                    for (int n = 0; n < 2; ++n) acc[a][b][m][n] = (f32x4){0.f, 0.f, 0.f, 0.f};
        cur = nxt; cA = nA; cB = nB; ++ui;
        if (wr == 1) PG8_BAR;
    }
    PG8_WAIT_V(0);
    PG8_BAR;
#undef PG8_SA
#undef PG8_SB
#undef PG8_STAGE
#undef PG8_LDA
#undef PG8_LDB
#undef PG8_MMA
#undef PG8_WAIT_V
#undef PG8_WAIT_L
#undef PG8_BAR
#undef PG8_SCHED
}

typedef f32x4 Acc[2][2][4][2];
struct OneUnit { int pm, pn; bool valid;
    __device__ __forceinline__ bool next(int i, Unit& u) const { if (i != 0 || !valid) return false; u.pm = pm; u.pn = pn; return true; } };

__device__ __forceinline__ u32x4 pack8(const f32x4 a, const f32x4 b) {
    u32x4 w; w.x = cvt_pk_bf16(a[0], a[1]); w.y = cvt_pk_bf16(a[2], a[3]); w.z = cvt_pk_bf16(b[0], b[1]); w.w = cvt_pk_bf16(b[2], b[3]); return w;
}
__device__ __forceinline__ void unpack8(const u32x4 w, f32x4& a, f32x4& b) {
    a = (f32x4){bf_lo(w.x), bf_hi(w.x), bf_lo(w.y), bf_hi(w.y)}; b = (f32x4){bf_lo(w.z), bf_hi(w.z), bf_lo(w.w), bf_hi(w.w)};
}

template <int MODE> struct EpiStd {
    bf16_t* O; const bf16_t* G; int ldc;
    __device__ __forceinline__ void operator()(const Acc& acc, const Unit& u, int wr, int wc, int fr, int fq) const {
        const int row0 = u.pm * BM + wr * 64 + fr, col0 = u.pn * BM + wc * 32 + 8 * fq;
#pragma unroll
        for (int ai = 0; ai < 2; ++ai)
#pragma unroll
            for (int m = 0; m < 4; ++m) {
                const size_t ro = (size_t)(row0 + ai * HALF + m * 16) * ldc + col0;
#pragma unroll
                for (int bj = 0; bj < 2; ++bj) {
                    f32x4 v0 = acc[ai][bj][m][0], v1 = acc[ai][bj][m][1];
                    if (MODE == 1 || MODE == 2) { f32x4 g0, g1; unpack8(*(const u32x4*)(G + ro + bj * HALF), g0, g1); v0 = v0 * g0; v1 = v1 * g1; }
                    if (MODE == 2) { f32x4 o0, o1; unpack8(*(const u32x4*)(O + ro + bj * HALF), o0, o1); v0 = v0 + o0; v1 = v1 + o1; }
                    if (MODE == 3) { f32x4 o0, o1; unpack8(*(const u32x4*)(O + ro + bj * HALF), o0, o1);
#pragma unroll
                        for (int i = 0; i < 4; ++i) { v0[i] = sigmoidf_(v0[i]) * o0[i]; v1[i] = sigmoidf_(v1[i]) * o1[i]; } }
                    *(u32x4*)(O + ro + bj * HALF) = pack8(v0, v1);
                }
            }
    }
};

struct EpiPartial {
    float* FS;
    __device__ __forceinline__ void operator()(const Acc& acc, const Unit& u, int wr, int wc, int fr, int fq) const {
        const int row0 = (u.pm - MP / BM) * BM + wr * 64 + fr, col0 = u.pn * BM + wc * 32 + 8 * fq;
#pragma unroll
        for (int ai = 0; ai < 2; ++ai)
#pragma unroll
            for (int m = 0; m < 4; ++m) {
                float* p = FS + (size_t)(row0 + ai * HALF + m * 16) * D + col0;
#pragma unroll
                for (int bj = 0; bj < 2; ++bj) { *(f32x4*)(p + bj * HALF) = acc[ai][bj][m][0]; *(f32x4*)(p + bj * HALF + 4) = acc[ai][bj][m][1]; }
            }
    }
};

struct EpiGateUp {
    bf16_t* O; const float* rs; const float* ss;
    __device__ __forceinline__ void operator()(const Acc& acc, const Unit& u, int wr, int wc, int fr, int fq) const {
        const int row0 = u.pm * BM + wr * 64 + fr, col0 = u.pn * HALF + wc * 32 + 8 * fq;
#pragma unroll
        for (int ai = 0; ai < 2; ++ai)
#pragma unroll
            for (int m = 0; m < 4; ++m) {
                f32x4 v0, v1; const int rrow = row0 + ai * HALF + m * 16; const float rr = (ss != nullptr && u.pm < MP / BM) ? __builtin_amdgcn_rsqf(ss[rrow] * (1.f / D) + EPS) : rs[rrow];
#pragma unroll
                for (int i = 0; i < 4; ++i) { const float g0 = acc[ai][0][m][0][i] * rr, g1 = acc[ai][0][m][1][i] * rr;
                    v0[i] = g0 * sigmoidf_(g0) * (acc[ai][1][m][0][i] * rr); v1[i] = g1 * sigmoidf_(g1) * (acc[ai][1][m][1][i] * rr); }
                *(u32x4*)(O + (size_t)(row0 + ai * HALF + m * 16) * FF + col0) = pack8(v0, v1);
            }
    }
};

struct EpiWin {
    bf16_t *Q, *Kb, *Vt, *Vts, *Sb, *Bg, *SA, *SC; float* out; const float* rstd_; const float* ss;
    __device__ __forceinline__ float rstd_of(int r) const { return r < MP ? __builtin_amdgcn_rsqf(ss[r] * (1.f / D) + EPS) : rstd_[r]; }
    __device__ __forceinline__ void operator()(const Acc& acc, const Unit& u, int wr, int wc, int fr, int fq) const {
        const int pn = u.pn, pm = u.pm;
        const int row0 = pm * BM + wr * 64 + fr, cl0 = wc * 32 + 8 * fq;
        const bool samp = pm >= MP / BM;
        if (pn < 2 || pn >= 10) {
            bf16_t* base; int ldc, colt; float sc = 1.f; bool sg = false;
            if (pn < 2) { base = Q; ldc = 512; colt = pn * 256; sc = 0.125f * 1.4426950408889634f; }
            else if (pn < 12) { base = Bg; ldc = 512; colt = (pn - 10) * 256; }
            else if (pn < 16) { base = SA; ldc = 1024; colt = (pn - 12) * 256; sg = true; }
            else { base = SC; ldc = 1024; colt = (pn - 16) * 256; sg = true; }
#pragma unroll
            for (int ai = 0; ai < 2; ++ai)
#pragma unroll
                for (int m = 0; m < 4; ++m) {
                    const size_t ro = (size_t)(row0 + ai * HALF + m * 16) * ldc + colt + cl0; const float rr = sc * rstd_of(row0 + ai * HALF + m * 16);
#pragma unroll
                    for (int bj = 0; bj < 2; ++bj) {
                        f32x4 v0 = acc[ai][bj][m][0] * rr, v1 = acc[ai][bj][m][1] * rr;
                        if (sg) {
#pragma unroll
                            for (int i = 0; i < 4; ++i) { v0[i] = sigmoidf_(v0[i]); v1[i] = sigmoidf_(v1[i]); } }
                        *(u32x4*)(base + ro + bj * HALF) = pack8(v0, v1);
                    }
                }
        } else if (pn < 4) {
            const int colt = (pn - 2) * 256 + cl0;
            const bool wout = samp || ((pm & 31) >= 30);
#pragma unroll
            for (int ai = 0; ai < 2; ++ai)
#pragma unroll
                for (int m = 0; m < 4; ++m) {
                    const int r = row0 + ai * HALF + m * 16;
                    size_t krow, orow;
                    if (samp) { const int rs = r - MP; krow = (size_t)MP + (size_t)(rs >> 4) * SKV + 512 + (rs & 15); orow = O_KS + (size_t)rs * 512; }
                    else { krow = r; orow = O_KP + ((size_t)(r >> 13) * 512 + ((r & 8191) - 7680)) * 512; }
                    const float rr = rstd_of(r);
#pragma unroll
                    for (int bj = 0; bj < 2; ++bj) {
                        const f32x4 v0 = acc[ai][bj][m][0] * rr, v1 = acc[ai][bj][m][1] * rr;
                        *(u32x4*)(Kb + krow * 512 + colt + bj * HALF) = pack8(v0, v1);
                        if (wout) { *(f32x4*)(out + orow + colt + bj * HALF) = v0; *(f32x4*)(out + orow + colt + bj * HALF + 4) = v1; }
                    }
                }
        } else if (pn < 6) {
            const int colt = (pn - 4) * 256 + cl0;
            const bool wout = samp || ((pm & 31) >= 30);
#pragma unroll
            for (int ai = 0; ai < 2; ++ai)
#pragma unroll
                for (int m = 0; m < 4; ++m) {
                    const int r = row0 + ai * HALF + m * 16;
                    bf16_t* vb; size_t pitch, orow;
                    if (samp) { const int rs = r - MP; vb = Vts + (size_t)(rs >> 4) * 512 * SKV + 512 + (rs & 15); pitch = SKV; orow = O_VS + (size_t)rs * 512; }
                    else { vb = Vt + (size_t)(r >> 13) * 512 * SEQ + (r & 8191); pitch = SEQ; orow = O_VP + ((size_t)(r >> 13) * 512 + ((r & 8191) - 7680)) * 512; }
                    const float rr = rstd_of(r);
#pragma unroll
                    for (int bj = 0; bj < 2; ++bj) {
#pragma unroll
                        for (int n = 0; n < 2; ++n) {
                            const f32x4 vv = acc[ai][bj][m][n] * rr;
                            const unsigned p0 = cvt_pk_bf16(vv[0], vv[1]), p1 = cvt_pk_bf16(vv[2], vv[3]);
                            bf16_t* vp = vb + (size_t)(colt + bj * HALF + 4 * n) * pitch;
                            vp[0] = (bf16_t)(p0 & 0xffffu); vp[pitch] = (bf16_t)(p0 >> 16); vp[2 * pitch] = (bf16_t)(p1 & 0xffffu); vp[3 * pitch] = (bf16_t)(p1 >> 16);
                        }
                        if (wout) { *(f32x4*)(out + orow + colt + bj * HALF) = acc[ai][bj][m][0] * rr; *(f32x4*)(out + orow + colt + bj * HALF + 4) = acc[ai][bj][m][1] * rr; }
                    }
                }
        } else {
            const int colt = (pn - 6) * 128 + cl0;
#pragma unroll
            for (int ai = 0; ai < 2; ++ai)
#pragma unroll
                for (int m = 0; m < 4; ++m) {
                    const int r = row0 + ai * HALF + m * 16;
                    const float rr = rstd_of(r), rr2 = rr * rr;
                    const f32x4 v0 = acc[ai][0][m][0] * acc[ai][1][m][0] * rr2, v1 = acc[ai][0][m][1] * acc[ai][1][m][1] * rr2;
                    *(u32x4*)(Sb + (size_t)r * 512 + colt) = pack8(v0, v1);
                    if (samp) { const int rs = r - MP; if ((rs & 15) >= 14) { float* o = out + O_CS + ((size_t)(rs >> 4) * 2 + ((rs & 15) - 14)) * 512 + colt; *(f32x4*)o = v0; *(f32x4*)(o + 4) = v1; } }
                    else if ((r & 8191) >= 8190) { float* o = out + O_CP + ((size_t)(r >> 13) * 2 + ((r & 8191) - 8190)) * 512 + colt; *(f32x4*)o = v0; *(f32x4*)(o + 4) = v1; }
                }
        }
    }
};
}

struct Args { const float* in[22]; float* out; unsigned char* ws; int ph_lo, ph_hi; };
enum { I_XP = 0, I_XS, I_CK, I_CV, I_CC, I_PP, I_PS, I_NG, I_W1G, I_W1U, I_W1D, I_WIN, I_CW, I_RB, I_WAO, I_WCO, I_WOUT, I_W2G, I_W2U, I_W2D, I_WPG, I_WPP };

__device__ __forceinline__ void tr_tile(LAS float* t, const float* src, int ldS, int k0, int c0, bf16_t* dst, int ldD, int r0, const float* gk) {
    const int tid = threadIdx.x, ty = tid >> 4, tx = tid & 15;
#pragma unroll
    for (int i = 0; i < 2; ++i) { const int k = ty + 32 * i; f32x4 v = *(const f32x4*)(src + (size_t)(k0 + k) * ldS + c0 + 4 * tx); if (gk) v = v * gk[k0 + k];
        t[k * 65 + 4 * tx + 0] = v[0]; t[k * 65 + 4 * tx + 1] = v[1]; t[k * 65 + 4 * tx + 2] = v[2]; t[k * 65 + 4 * tx + 3] = v[3]; }
    __syncthreads();
    const int c = tid >> 3, kk = (tid & 7) * 8;
    u32x4 w;
    w.x = cvt_pk_bf16(t[(kk + 0) * 65 + c], t[(kk + 1) * 65 + c]); w.y = cvt_pk_bf16(t[(kk + 2) * 65 + c], t[(kk + 3) * 65 + c]);
    w.z = cvt_pk_bf16(t[(kk + 4) * 65 + c], t[(kk + 5) * 65 + c]); w.w = cvt_pk_bf16(t[(kk + 6) * 65 + c], t[(kk + 7) * 65 + c]);
    *(u32x4*)(dst + (size_t)(r0 + c) * ldD + k0 + kk) = w;
    __syncthreads();
}

template <class CMap>
__device__ __forceinline__ void tr_matrix(LAS float* t, int& job, int nw, int me, const float* src, int ldS, int K, int ncb, bf16_t* dst, int ldD, const CMap& cmap, const float* gk = nullptr) {
    const int nkb = K / 64, ntile = nkb * ncb;
    int first = (me - job % nw + nw) % nw;
    for (int i = first; i < ntile; i += nw) { const int cb = i / nkb, kb = i % nkb; int c0, r0; cmap(cb, c0, r0); tr_tile(t, src, ldS, kb * 64, c0, dst, ldD, r0, gk); }
    job += ntile;
}

struct NormP { const bf16_t* F; const float* FS; int nsplit; const bf16_t* hb_in; bf16_t* hb_out; float* fout; const float* gpost; float alpha; float* rs; bf16_t* AN; };
template <int HIN>
__device__ __forceinline__ void norm_load_h(const Args& a, const NormP& p, int r, int lane, f32x4 (&h)[4]) {
    if (HIN == 0) { const float* hin = r < MP ? a.in[I_XP] + (size_t)r * D : a.in[I_XS] + (size_t)(r - MP) * D;
#pragma unroll
        for (int i = 0; i < 4; ++i) h[i] = __builtin_nontemporal_load((const f32x4*)(hin + 256 * i + 4 * lane)); }
    else {
#pragma unroll
        for (int i = 0; i < 4; ++i) { const u32x2 w = __builtin_nontemporal_load((const u32x2*)(p.hb_in + (size_t)r * D + 256 * i + 4 * lane)); h[i] = (f32x4){bf_lo(w.x), bf_hi(w.x), bf_lo(w.y), bf_hi(w.y)}; } }
}
template <bool HAS_F, int OUTH, int ANM>
__device__ __forceinline__ void norm_finish(const NormP& p, int r, int lane, f32x4 (&h)[4], const f32x4 (&f)[4]) {
    if (HAS_F) {
        float ss = 0.f;
#pragma unroll
        for (int i = 0; i < 4; ++i) ss += f[i][0] * f[i][0] + f[i][1] * f[i][1] + f[i][2] * f[i][2] + f[i][3] * f[i][3];
        ss = wave_sum(ss);
        const float rs = p.alpha * __builtin_amdgcn_rsqf(ss * (1.f / D) + EPS);
#pragma unroll
        for (int i = 0; i < 4; ++i) { const f32x4 g = *(const f32x4*)(p.gpost + 256 * i + 4 * lane); h[i] = h[i] + f[i] * g * rs; }
    }
    if (OUTH == 2) {
#pragma unroll
        for (int i = 0; i < 4; ++i) __builtin_nontemporal_store(h[i], (f32x4*)(p.fout + (size_t)r * D + 256 * i + 4 * lane));
    }
    if (OUTH == 1) {
#pragma unroll
        for (int i = 0; i < 4; ++i) { u32x2 w; w.x = cvt_pk_bf16(h[i][0], h[i][1]); w.y = cvt_pk_bf16(h[i][2], h[i][3]); __builtin_nontemporal_store(w, (u32x2*)(p.hb_out + (size_t)r * D + 256 * i + 4 * lane)); }
    }
    if (ANM == 1) {
        float ss = 0.f;
#pragma unroll
        for (int i = 0; i < 4; ++i) ss += h[i][0] * h[i][0] + h[i][1] * h[i][1] + h[i][2] * h[i][2] + h[i][3] * h[i][3];
        ss = wave_sum(ss);
        if (lane == 0) p.rs[r] = __builtin_amdgcn_rsqf(ss * (1.f / D) + EPS);
    }
    if (ANM == 2) {
#pragma unroll
        for (int i = 0; i < 4; ++i) { u32x2 w; w.x = cvt_pk_bf16(h[i][0], h[i][1]); w.y = cvt_pk_bf16(h[i][2], h[i][3]); *(u32x2*)(p.AN + (size_t)r * D + 256 * i + 4 * lane) = w; }
    }
}
template <int HIN, bool HAS_F, int OUTH, int ANM>
__device__ __forceinline__ void norm_rows(const Args& a, const NormP p) {
    const int lane = threadIdx.x & 63, wv = threadIdx.x >> 6, G = gridDim.x;
    constexpr int NR = 8;
    const int rows_main = p.FS ? MP : MT;
    for (int rb = blockIdx.x * 8 + wv; rb < rows_main; rb += G * 8 * NR) {
        int rj[NR]; bool vj[NR];
#pragma unroll
        for (int j = 0; j < NR; ++j) { vj[j] = rb + j * G * 8 < rows_main; rj[j] = vj[j] ? rb + j * G * 8 : rb; }
        f32x4 h[NR][4], f[NR][4];
#pragma unroll
        for (int j = 0; j < NR; ++j) { const int r = rj[j];
            norm_load_h<HIN>(a, p, r, lane, h[j]);
            if (HAS_F) {
#pragma unroll
                for (int i = 0; i < 4; ++i) { const u32x2 w = __builtin_nontemporal_load((const u32x2*)(p.F + (size_t)r * D + 256 * i + 4 * lane)); f[j][i] = (f32x4){bf_lo(w.x), bf_hi(w.x), bf_lo(w.y), bf_hi(w.y)}; }
            }
        }
#pragma unroll
        for (int j = 0; j < NR; ++j) if (vj[j]) norm_finish<HAS_F, OUTH, ANM>(p, rj[j], lane, h[j], f[j]);
    }
    if (HAS_F && p.FS) {
        for (int r = MP + blockIdx.x * 8 + wv; r < MT; r += G * 8) {
            f32x4 h[4], f[4];
            norm_load_h<HIN>(a, p, r, lane, h);
#pragma unroll
            for (int i = 0; i < 4; ++i) { f32x4 v = *(const f32x4*)(p.FS + (size_t)(r - MP) * D + 256 * i + 4 * lane);
                for (int k = 1; k < p.nsplit; ++k) v = v + *(const f32x4*)(p.FS + ((size_t)k * MS + (r - MP)) * D + 256 * i + 4 * lane);
                f[i] = v; }
            norm_finish<HAS_F, OUTH, ANM>(p, r, lane, h, f);
        }
    }
}

constexpr int CW_PANEL = 4096, CW_PANEL_STRIDE = 512, CW_SAMPLE = CW_PANEL + 4 * CW_PANEL_STRIDE;
__device__ __forceinline__ unsigned cw_ld(unsigned* p)              { return __hip_atomic_load(p, __ATOMIC_RELAXED, __HIP_MEMORY_SCOPE_AGENT); }
__device__ __forceinline__ unsigned cw_add(unsigned* p, unsigned v) { return __hip_atomic_fetch_add(p, v, __ATOMIC_RELAXED, __HIP_MEMORY_SCOPE_AGENT); }
__device__ __forceinline__ void arrive_and_wait(unsigned* cnt, unsigned need, bool arrive, bool wait) {
    asm volatile("s_waitcnt vmcnt(0)" ::: "memory");
    __syncthreads();
    if (threadIdx.x == 0) {
        if (arrive) { __builtin_amdgcn_fence(__ATOMIC_RELEASE, "agent"); asm volatile("s_waitcnt vmcnt(0)" ::: "memory"); (void)cw_add(cnt, 1u); }
        if (wait) { unsigned sp = 0; while (cw_ld(cnt) < need) { __builtin_amdgcn_s_sleep(1); if (++sp > (1u << 24)) break; }
            __builtin_amdgcn_fence(__ATOMIC_ACQUIRE, "agent"); asm volatile("s_waitcnt vmcnt(0)" ::: "memory"); }
    }
    __syncthreads();
}

template <int PH>
struct EpiX {
    unsigned char* ws; float* out; const float* ng; LAS unsigned char* lds;
    __device__ __forceinline__ void operator()(f32x4 (&acc)[2][2][4][2], const pg8::Unit& u, int wr, int wc, int fr, int fq) const {
        using namespace pg8;
        const int tid = threadIdx.x;
        LAS float* lpart = (LAS float*)(lds + 131072 + 1024);
        LAS float* lrs = lpart + 1024;
        const float* gpost = ng + (PH == 0 ? 1 : PH == 1 ? 3 : PH == 2 ? 5 : 6) * D;
        const float alpha = (PH == 0 || PH == 2) ? 0.5f : 1.f;
        const bf16_t* hin = PH == 3 ? (const bf16_t*)(ws + WS_AN) : (const bf16_t*)out;
        const int rloc0 = wr * 64 + fr, col0 = u.pn * BM + wc * 32 + 8 * fq;
        if (PH == 3) {
            const bf16_t* P = (const bf16_t*)(ws + WS_F);
#pragma unroll
            for (int ai = 0; ai < 2; ++ai)
#pragma unroll
                for (int m = 0; m < 4; ++m) { const size_t ro = (size_t)(u.pm * BM + rloc0 + ai * HALF + m * 16) * D + col0;
#pragma unroll
                    for (int bj = 0; bj < 2; ++bj) { f32x4 p0, p1; unpack8(*(const u32x4*)(P + ro + bj * HALF), p0, p1);
#pragma unroll
                        for (int i = 0; i < 4; ++i) { acc[ai][bj][m][0][i] = sigmoidf_(acc[ai][bj][m][0][i]) * p0[i]; acc[ai][bj][m][1][i] = sigmoidf_(acc[ai][bj][m][1][i]) * p1[i]; } } }
        }
#pragma unroll
        for (int ai = 0; ai < 2; ++ai)
#pragma unroll
            for (int m = 0; m < 4; ++m) {
                float sq = 0.f;
#pragma unroll
                for (int bj = 0; bj < 2; ++bj)
#pragma unroll
                    for (int n = 0; n < 2; ++n)
#pragma unroll
                        for (int i = 0; i < 4; ++i) sq += acc[ai][bj][m][n][i] * acc[ai][bj][m][n][i];
                sq += __shfl_xor(sq, 16); sq += __shfl_xor(sq, 32);
                if (fq == 0) lpart[wc * 256 + rloc0 + ai * HALF + m * 16] = sq;
            }
        __syncthreads();
        float* X = (float*)(ws + WS_X) + ((size_t)(PH * 258 + u.pm) * 4) * 256;
        if (tid < 256) __hip_atomic_store(X + u.pn * 256 + tid, lpart[tid] + lpart[256 + tid] + lpart[512 + tid] + lpart[768 + tid], __ATOMIC_RELAXED, __HIP_MEMORY_SCOPE_AGENT);
        asm volatile("s_waitcnt vmcnt(0)" ::: "memory");
        __syncthreads();
        if (tid == 0) { unsigned* cnt = (unsigned*)(ws + WS_CTL) + CW_PANEL + PH * CW_PANEL_STRIDE + u.pm; (void)cw_add(cnt, 1u);
            unsigned sp = 0; while (cw_ld(cnt) < 4u) { __builtin_amdgcn_s_sleep(1); if (++sp > (1u << 24)) break; } }
        __syncthreads();
        if (tid < 256) { float tot = 0.f;
#pragma unroll
            for (int q = 0; q < 4; ++q) tot += __hip_atomic_load(X + q * 256 + tid, __ATOMIC_RELAXED, __HIP_MEMORY_SCOPE_AGENT);
            lrs[tid] = alpha * __builtin_amdgcn_rsqf(tot * (1.f / D) + EPS); }
        __syncthreads();
        f32x4 g[2][2];
#pragma unroll
        for (int bj = 0; bj < 2; ++bj) { g[bj][0] = *(const f32x4*)(gpost + col0 + bj * HALF); g[bj][1] = *(const f32x4*)(gpost + col0 + bj * HALF + 4); }
#pragma unroll
        for (int ai = 0; ai < 2; ++ai)
#pragma unroll
            for (int m = 0; m < 4; ++m) {
                const int rloc = rloc0 + ai * HALF + m * 16; const float rs = lrs[rloc];
                const size_t ro = (size_t)(u.pm * BM + rloc) * D + col0;
                float sq = 0.f;
#pragma unroll
                for (int bj = 0; bj < 2; ++bj) {
                    f32x4 h0, h1; unpack8(*(const u32x4*)(hin + ro + bj * HALF), h0, h1);
                    h0 = h0 + acc[ai][bj][m][0] * g[bj][0] * rs; h1 = h1 + acc[ai][bj][m][1] * g[bj][1] * rs;
                    if (PH < 2) { const u32x4 w = pack8(h0, h1); *(u32x4*)((bf16_t*)out + ro + bj * HALF) = w; f32x4 r0, r1; unpack8(w, r0, r1);
#pragma unroll
                        for (int i = 0; i < 4; ++i) sq += r0[i] * r0[i] + r1[i] * r1[i]; }
                    if (PH == 2) *(u32x4*)((bf16_t*)(ws + WS_AN) + ro + bj * HALF) = pack8(h0, h1);
                    if (PH == 3) { *(f32x4*)(out + ro + bj * HALF) = h0; *(f32x4*)(out + ro + bj * HALF + 4) = h1; }
                }
                if (PH < 2) { sq += __shfl_xor(sq, 16); sq += __shfl_xor(sq, 32); if (fq == 0) lpart[wc * 256 + rloc] = sq; }
            }
        if (PH < 2) {
            __syncthreads();
            if (tid < 256) (void)__hip_atomic_fetch_add((float*)(ws + WS_SS) + (size_t)PH * MT + u.pm * BM + tid, lpart[tid] + lpart[256 + tid] + lpart[512 + tid] + lpart[768 + tid], __ATOMIC_RELAXED, __HIP_MEMORY_SCOPE_AGENT);
        }
        __syncthreads();
    }
};
template <int PH> __device__ __forceinline__ NormP fused_normp(unsigned char* ws, float* out, const float* ng) {
    bf16_t* Fb = (bf16_t*)(ws + WS_F); bf16_t* HBb = (bf16_t*)out; bf16_t* ANb = (bf16_t*)(ws + WS_AN); float* FSb = (float*)(ws + WS_FS); float* RSb = (float*)(ws + WS_RS);
    if (PH == 0) return NormP{Fb, FSb, 11, HBb, HBb, nullptr, ng + 1 * D, 0.5f, RSb + 1 * MT, nullptr};
    if (PH == 1) return NormP{Fb, FSb, 4, HBb, HBb, nullptr, ng + 3 * D, 1.f, RSb + 2 * MT, nullptr};
    if (PH == 2) return NormP{Fb, FSb, 11, HBb, nullptr, nullptr, ng + 5 * D, 0.5f, nullptr, ANb};
    return NormP{Fb, FSb, 4, ANb, nullptr, out, ng + 6 * D, 1.f, nullptr, nullptr};
}
template <int OUTH, int ANM, bool PLE = false>
__device__ __forceinline__ void sample_norm(const Args& a, const NormP& p, unsigned* cnt, int nitems) {
    const int G = gridDim.x, lane = threadIdx.x & 63, wv = threadIdx.x >> 6;
    arrive_and_wait(cnt, (unsigned)nitems, (int)blockIdx.x < nitems, (int)blockIdx.x * 8 < MS);
    for (int r = MP + blockIdx.x * 8 + wv; r < MT; r += G * 8) {
        f32x4 h[4], f[4];
        norm_load_h<1>(a, p, r, lane, h);
#pragma unroll
        for (int i = 0; i < 4; ++i) { f32x4 v = *(const f32x4*)(p.FS + (size_t)(r - MP) * D + 256 * i + 4 * lane);
            for (int k = 1; k < p.nsplit; ++k) v = v + *(const f32x4*)(p.FS + ((size_t)k * MS + (r - MP)) * D + 256 * i + 4 * lane);
            if (PLE) { const u32x2 w = *(const u32x2*)(p.F + (size_t)r * D + 256 * i + 4 * lane);
                v[0] = sigmoidf_(v[0]) * bf_lo(w.x); v[1] = sigmoidf_(v[1]) * bf_hi(w.x); v[2] = sigmoidf_(v[2]) * bf_lo(w.y); v[3] = sigmoidf_(v[3]) * bf_hi(w.y); }
            f[i] = v; }
        norm_finish<true, OUTH, ANM>(p, r, lane, h, f);
    }
}

__device__ __forceinline__ float max3f(float a, float b, float c) { float r; asm("v_max3_f32 %0, %1, %2, %3" : "=v"(r) : "v"(a), "v"(b), "v"(c)); return r; }
constexpr float LOG2E = 1.4426950408889634f;
constexpr int AT_KS = 0, AT_VS = 9216, AT_BUF = 18432, AT_TB = 2 * 18432, AT_ROW = 144;
__device__ __forceinline__ int crow(int r, int hi) { return (r & 3) + 8 * (r >> 2) + 4 * hi; }

__device__ __forceinline__ void attn_unit(LAS unsigned char* lds, const bf16_t* qb, bf16_t* ob, const bf16_t* kbase, const bf16_t* vbase, int vpitch,
                                          const float* tb_g, int c0, int nq, bool samp) {
    const int tid = threadIdx.x, lane = tid & 63, w = __builtin_amdgcn_readfirstlane(tid >> 6), l32 = lane & 31, hi = lane >> 5;
    const int cw = c0 + (w >> 1), half = w & 1;
    const bool wact = (w >> 1) < nq && (!samp || w == 0);
    LAS float* tb = (LAS float*)(lds + AT_TB);
    __syncthreads();
    if (tid < 255) { const int d = tid - 63; tb[tid] = (tb_g[(d > 128 ? 128 : d) + 128] - tb_g[256]) * LOG2E; }
    bf16x8 qf[4];
    {
        int qr = (w >> 1) * 64 + half * 32 + l32; if (samp) qr &= 15; if (!wact) qr = 0;
        const bf16_t* qp = qb + (size_t)qr * 512 + 8 * hi;
#pragma unroll
        for (int ks = 0; ks < 4; ++ks) qf[ks] = *(const bf16x8*)(qp + 16 * ks);
    }
    f32x16 o0, o1;
#pragma unroll
    for (int i = 0; i < 16; ++i) { o0[i] = 0.f; o1[i] = 0.f; }
    float mrun = -1e30f, lrun = 0.f;
    const int kc_lo = c0 - 8 < 0 ? 0 : c0 - 8, kc_hi = c0 + nq - 1;
    const int rr = tid >> 3, seg = tid & 7;
    const bf16_t* kg = kbase + (size_t)rr * 512 + seg * 8;
    const bf16_t* vg = vbase + (size_t)rr * vpitch + seg * 8;
    u32x4 kv = *(const u32x4*)(kg + (size_t)(kc_lo * 64) * 512), vv = *(const u32x4*)(vg + kc_lo * 64);
    int buf = 0;
    for (int kc = kc_lo; kc <= kc_hi; ++kc) {
        LAS unsigned char* lb = lds + buf * AT_BUF;
        *(LAS u32x4*)(lb + AT_KS + rr * AT_ROW + seg * 16) = kv;
        *(LAS u32x4*)(lb + AT_VS + rr * AT_ROW + seg * 16) = vv;
        __syncthreads();
        if (kc < kc_hi) { kv = *(const u32x4*)(kg + (size_t)((kc + 1) * 64) * 512); vv = *(const u32x4*)(vg + (kc + 1) * 64); }
        buf ^= 1;
        if (wact && kc >= cw - 8 && kc <= cw) {
            f32x16 s0, s1;
            if (cw - kc >= 3) {
#pragma unroll
                for (int i = 0; i < 16; ++i) { s0[i] = 0.f; s1[i] = 0.f; }
            } else {
                const LAS float* ep = tb + ((cw - kc) * 64 + half * 32 + l32 - 4 * hi + 4);
#pragma unroll
                for (int i = 0; i < 16; ++i) { s0[i] = ep[59 - ((i & 3) + 8 * (i >> 2))]; s1[i] = ep[27 - ((i & 3) + 8 * (i >> 2))]; }
            }
#pragma unroll
            for (int ks = 0; ks < 4; ++ks) {
                const bf16x8 ka = *(const LAS bf16x8*)(lb + AT_KS + l32 * AT_ROW + ks * 32 + hi * 16);
                const bf16x8 kb = *(const LAS bf16x8*)(lb + AT_KS + (32 + l32) * AT_ROW + ks * 32 + hi * 16);
                s0 = __builtin_amdgcn_mfma_f32_32x32x16_bf16(ka, qf[ks], s0, 0, 0, 0);
                s1 = __builtin_amdgcn_mfma_f32_32x32x16_bf16(kb, qf[ks], s1, 0, 0, 0);
            }
            if (samp && kc == 8) {
#pragma unroll
                for (int i = 0; i < 16; ++i) { if (i >= 8) s0[i] = -1e30f; s1[i] = -1e30f; } }
            float mx = max3f(s0[0], s0[1], s1[0]);
            mx = max3f(mx, s1[1], s0[2]);
#pragma unroll
            for (int i = 3; i < 16; i += 2) { mx = max3f(mx, s0[i], s0[i < 15 ? i + 1 : i]); }
#pragma unroll
            for (int i = 2; i < 16; i += 2) { mx = max3f(mx, s1[i], s1[i + 1]); }
            mx = fmaxf(mx, __shfl_xor(mx, 32));
            const float mn = fmaxf(mrun, mx);
            if (__builtin_amdgcn_ballot_w64(mn > mrun) != 0) {
                const float alpha = __builtin_amdgcn_exp2f(mrun - mn);
                lrun *= alpha; mrun = mn;
#pragma unroll
                for (int i = 0; i < 16; ++i) { o0[i] *= alpha; o1[i] *= alpha; }
            }
            float rs = 0.f;
#pragma unroll
            for (int i = 0; i < 16; ++i) { s0[i] = __builtin_amdgcn_exp2f(s0[i] - mn); s1[i] = __builtin_amdgcn_exp2f(s1[i] - mn); rs += s0[i] + s1[i]; }
            rs += __shfl_xor(rs, 32);
            lrun += rs;
            bf16x8 pf[4];
#pragma unroll
            for (int kb2 = 0; kb2 < 2; ++kb2) {
                u32x4 a, b;
                a.x = cvt_pk_bf16(s0[8 * kb2 + 0], s0[8 * kb2 + 1]); a.y = cvt_pk_bf16(s0[8 * kb2 + 2], s0[8 * kb2 + 3]); a.z = cvt_pk_bf16(s0[8 * kb2 + 4], s0[8 * kb2 + 5]); a.w = cvt_pk_bf16(s0[8 * kb2 + 6], s0[8 * kb2 + 7]);
                b.x = cvt_pk_bf16(s1[8 * kb2 + 0], s1[8 * kb2 + 1]); b.y = cvt_pk_bf16(s1[8 * kb2 + 2], s1[8 * kb2 + 3]); b.z = cvt_pk_bf16(s1[8 * kb2 + 4], s1[8 * kb2 + 5]); b.w = cvt_pk_bf16(s1[8 * kb2 + 6], s1[8 * kb2 + 7]);
                pf[kb2] = __builtin_bit_cast(bf16x8, a); pf[2 + kb2] = __builtin_bit_cast(bf16x8, b);
            }
#pragma unroll
            for (int kt = 0; kt < 4; ++kt) {
                const s16x4 a0 = *(const LAS s16x4*)(lb + AT_VS + l32 * AT_ROW + (16 * kt + 4 * hi) * 2), a1 = *(const LAS s16x4*)(lb + AT_VS + l32 * AT_ROW + (16 * kt + 4 * hi) * 2 + 16);
                const s16x4 b0 = *(const LAS s16x4*)(lb + AT_VS + (32 + l32) * AT_ROW + (16 * kt + 4 * hi) * 2), b1 = *(const LAS s16x4*)(lb + AT_VS + (32 + l32) * AT_ROW + (16 * kt + 4 * hi) * 2 + 16);
                const bf16x8 va = (bf16x8){a0[0], a0[1], a0[2], a0[3], a1[0], a1[1], a1[2], a1[3]}, vb = (bf16x8){b0[0], b0[1], b0[2], b0[3], b1[0], b1[1], b1[2], b1[3]};
                o0 = __builtin_amdgcn_mfma_f32_32x32x16_bf16(va, pf[kt], o0, 0, 0, 0);
                o1 = __builtin_amdgcn_mfma_f32_32x32x16_bf16(vb, pf[kt], o1, 0, 0, 0);
            }
        }
    }
    if (wact) {
        const int qr = (w >> 1) * 64 + half * 32 + l32;
        if (!samp || qr < 16) {
            const float inv = 1.f / lrun;
            bf16_t* op = ob + (size_t)qr * 512 + 4 * hi;
#pragma unroll
            for (int g = 0; g < 4; ++g) {
                u32x2 x, y;
                x.x = cvt_pk_bf16(o0[4 * g] * inv, o0[4 * g + 1] * inv); x.y = cvt_pk_bf16(o0[4 * g + 2] * inv, o0[4 * g + 3] * inv);
                y.x = cvt_pk_bf16(o1[4 * g] * inv, o1[4 * g + 1] * inv); y.y = cvt_pk_bf16(o1[4 * g + 2] * inv, o1[4 * g + 3] * inv);
                *(u32x2*)(op + 8 * g) = x; *(u32x2*)(op + 32 + 8 * g) = y;
            }
        }
    }
}

#define XB_TMO      128
#define XB_XCNT(j)  (256  + 64 * (j))
#define XB_XSUB(j)  (1280 + 64 * (j))
#define XB_XGEN(j)  (2304 + 64 * (j))
#define XB_TOP      3328
#define XB_TOPGEN   3392
#define XCD_BAR_WORDS 3456
#define XB_SPIN_CAP (1u << 22)
__device__ __forceinline__ unsigned xb_ld(unsigned* p)              { return __hip_atomic_load(p, __ATOMIC_RELAXED, __HIP_MEMORY_SCOPE_AGENT); }
__device__ __forceinline__ unsigned xb_add(unsigned* p, unsigned v) { return __hip_atomic_fetch_add(p, v, __ATOMIC_RELAXED, __HIP_MEMORY_SCOPE_AGENT); }
__device__ __forceinline__ unsigned xb_xcc_id() { return (unsigned)__builtin_amdgcn_s_getreg((3 << 11) | 20) & 0xFu; }
#define XB_SPIN(cond, bar) do { unsigned _sp = 0; while (cond) { __builtin_amdgcn_s_sleep(1); \
    if ((++_sp & 255u) == 0u) { if (xb_ld(&(bar)[XB_TMO])) break; if (_sp > XB_SPIN_CAP) { atomicAdd(&(bar)[XB_TMO], 1u); break; } } } } while (0)
struct XcdBarrier { unsigned* bar; unsigned x; volatile LAS unsigned* st; };
__device__ __forceinline__ XcdBarrier xcd_barrier_post(unsigned* bar, volatile LAS unsigned* st) {
    XcdBarrier b; b.bar = bar; b.x = xb_xcc_id(); b.st = st;
    if (threadIdx.x == 0) (void)xb_add(&bar[XB_XCNT(b.x)], 1u);
    return b;
}
__device__ __forceinline__ void xcd_barrier_complete(unsigned* bar, unsigned x, unsigned& nloc, unsigned& nx) {
    const unsigned G = gridDim.x * gridDim.y * gridDim.z;
    unsigned sum, cnt, mine, sp = 0u;
    for (;;) {
        sum = 0u; cnt = 0u; mine = 0u;
#pragma unroll
        for (unsigned j = 0; j < 16; ++j) { const unsigned c = xb_ld(&bar[XB_XCNT(j)]); sum += c; cnt += (c > 0u) ? 1u : 0u; mine = (j == x) ? c : mine; }
        if (sum == G) break;
        __builtin_amdgcn_s_sleep(1);
        if ((++sp & 255u) == 0u) { if (xb_ld(&bar[XB_TMO])) break; if (sp > XB_SPIN_CAP) { atomicAdd(&bar[XB_TMO], 1u); break; } }
    }
    nloc = mine > 0u ? mine : 1u; nx = cnt > 0u ? cnt : 1u;
}
__device__ __forceinline__ void xcd_barrier(const XcdBarrier& b) {
    asm volatile("s_waitcnt vmcnt(0)" ::: "memory");
    __syncthreads();
    if (threadIdx.x == 0) {
        unsigned* bar = b.bar;
        __builtin_amdgcn_s_waitcnt(0);
        unsigned nloc = b.st[0], nx = b.st[1];
        if (nloc == 0u) { xcd_barrier_complete(bar, b.x, nloc, nx); b.st[0] = nloc; b.st[1] = nx; }
        const unsigned old = xb_add(&bar[XB_XSUB(b.x)], 1u);
        const unsigned gen = old / nloc;
        if (old + 1u == (gen + 1u) * nloc) {
            __builtin_amdgcn_fence(__ATOMIC_RELEASE, "agent");
            asm volatile("s_waitcnt vmcnt(0)" ::: "memory");
            const unsigned og = xb_add(&bar[XB_TOP], 1u);
            const unsigned tg = og / nx;
            if (og + 1u == (tg + 1u) * nx) xb_add(&bar[XB_TOPGEN], 1u);
            else XB_SPIN(xb_ld(&bar[XB_TOPGEN]) == tg, bar);
            __builtin_amdgcn_fence(__ATOMIC_ACQUIRE, "agent");
            xb_add(&bar[XB_XGEN(b.x)], 1u);
            asm volatile("s_waitcnt vmcnt(0)" ::: "memory");
        } else {
            XB_SPIN(xb_ld(&bar[XB_XGEN(b.x)]) == gen, bar);
            __builtin_amdgcn_fence(__ATOMIC_ACQUIRE, "agent");
            asm volatile("s_waitcnt vmcnt(0)" ::: "memory");
        }
    }
    __syncthreads();
}

__global__ void __launch_bounds__(512, 2) fwd_kernel(Args a) {
    extern __shared__ __attribute__((aligned(16))) unsigned char lds_raw[];
    LAS unsigned char* lds = (LAS unsigned char*)lds_raw;
    cg::grid_group grid = cg::this_grid();
    const int lo = a.ph_lo, hi = a.ph_hi, G = gridDim.x, tid = threadIdx.x;
    volatile LAS unsigned* bst = (volatile LAS unsigned*)(lds + 131072 + 1008);
    if (tid == 0) { bst[0] = 0u; bst[1] = 0u; }
    __syncthreads();
    XcdBarrier xbar = xcd_barrier_post((unsigned*)(a.ws + WS_CTL), bst);
    unsigned char* ws = a.ws;
    bf16_t* W1GU = (bf16_t*)(ws + WS_W1GU); bf16_t* W1D = (bf16_t*)(ws + WS_W1D); bf16_t* WIN = (bf16_t*)(ws + WS_WIN); bf16_t* WAO = (bf16_t*)(ws + WS_WAO);
    bf16_t* WCO = (bf16_t*)(ws + WS_WCO); bf16_t* WOUT = (bf16_t*)(ws + WS_WOUT); bf16_t* W2GU = (bf16_t*)(ws + WS_W2GU); bf16_t* W2D = (bf16_t*)(ws + WS_W2D);
    bf16_t* WPG = (bf16_t*)(ws + WS_WPG); bf16_t* WPP = (bf16_t*)(ws + WS_WPP); bf16_t* PB = (bf16_t*)(ws + WS_PB); bf16_t* AN = (bf16_t*)(ws + WS_AN);
    bf16_t* F = (bf16_t*)(ws + WS_F); bf16_t* ACT = (bf16_t*)(ws + WS_ACT); bf16_t* Qb = (bf16_t*)(ws + WS_Q); bf16_t* Kb = (bf16_t*)(ws + WS_K);
    bf16_t* Vt = (bf16_t*)(ws + WS_VT); bf16_t* Vts = (bf16_t*)(ws + WS_VTS); bf16_t* Sb = (bf16_t*)(ws + WS_S); bf16_t* Bg = (bf16_t*)(ws + WS_BG);
    bf16_t* SA = (bf16_t*)(ws + WS_SA); bf16_t* SC = (bf16_t*)(ws + WS_SC); bf16_t* MM = (bf16_t*)(ws + WS_MM); bf16_t* ATT = (bf16_t*)(ws + WS_ATT); bf16_t* YC = (bf16_t*)(ws + WS_YC);
    float* H = a.out + O_Y;
    float* FSP = (float*)(ws + WS_FS);
    float* RS = (float*)(ws + WS_RS);
    unsigned* CW = (unsigned*)(ws + WS_CTL);
    bf16_t* HB = (bf16_t*)(a.out + O_Y);
    const float* ng = a.in[I_NG];
#define IN(k) (lo <= (k) && (k) < hi)
#define SEAM(k) do { if (IN(k) && IN((k) + 1)) xcd_barrier(xbar); } while (0)
    if (lo < 0) grid.sync();

    auto ident = [](int cb, int& c0, int& r0) { c0 = 64 * cb; r0 = 64 * cb; };
    auto gate = [](int cb, int& c0, int& r0) { c0 = 64 * cb; r0 = 256 * (cb >> 1) + 64 * (cb & 1); };
    auto up = [](int cb, int& c0, int& r0) { c0 = 64 * cb; r0 = 256 * (cb >> 1) + 128 + 64 * (cb & 1); };
    auto winmap = [](int db, int& c0, int& r0) { r0 = 64 * db; const int pn = db >> 2, q = db & 3;
        if (pn < 6) c0 = 256 * pn + 64 * q; else if (pn < 10) c0 = (q < 2 ? 1536 : 2560) + 128 * (pn - 6) + 64 * (q & 1); else if (pn < 12) c0 = 2048 + 256 * (pn - 10) + 64 * q; else c0 = 3072 + 256 * (pn - 12) + 64 * q; };
    if (IN(0)) {
        LAS float* t = (LAS float*)lds;
        int job = 0;
        tr_matrix(t, job, G, (int)blockIdx.x, a.in[I_W1G], FF, D, FF / 64, W1GU, D, gate, ng + 0 * D);
        tr_matrix(t, job, G, (int)blockIdx.x, a.in[I_W1U], FF, D, FF / 64, W1GU, D, up, ng + 0 * D);
        norm_rows<0, false, 1, 1>(a, NormP{nullptr, nullptr, 0, nullptr, HB, nullptr, nullptr, 0.f, RS + 0 * MT, nullptr});
    }
    SEAM(0);
    if (IN(1)) { pg8::Gemm g{HB, W1GU, D, D}; pg8::StaticOrder S; S.init(MT, 2 * FF, G, blockIdx.x); pg8::EpiGateUp E{ACT, RS + 0 * MT, nullptr}; pg8::gemm_phase(lds, g, S, E);
        constexpr int NB = (MT / 256) * (2 * FF / 256) % 256;
        const int me = (int)blockIdx.x - NB, nw = G - NB;
        if (me >= 0) { LAS float* t = (LAS float*)lds; int job = 0;
            tr_matrix(t, job, nw, me, a.in[I_W1D], D, FF, D / 64, W1D, FF, ident);
            tr_matrix(t, job, nw, me, a.in[I_WIN], DIN, D, DIN / 64, WIN, D, winmap, ng + 2 * D);
            tr_matrix(t, job, nw, me, a.in[I_WAO], D, DA, D / 64, WAO, DA, ident);
            tr_matrix(t, job, nw, me, a.in[I_WCO], D, DA, D / 64, WCO, DA, ident);
            tr_matrix(t, job, nw, me, a.in[I_WOUT], D, D, D / 64, WOUT, D, ident); } }
    SEAM(1);
    if (IN(2)) {
        { pg8::Gemm g{ACT, W1D, FF, FF}; pg8::StaticOrder S; S.init(MP, D, G, blockIdx.x);
          EpiX<0> E{ws, a.out, ng, lds}; pg8::gemm_phase(lds, g, S, E); }
        { const int id = blockIdx.x, ks = id % 11, t = id / 11;
          pg8::Gemm g2{ACT + ks * (FF / 11), W1D + ks * (FF / 11), FF / 11, FF}; pg8::OneUnit S2{MP / 256 + (t >> 2), t & 3, id < 8 * 11}; pg8::EpiPartial E2{FSP + (size_t)ks * MS * D}; pg8::gemm_phase(lds, g2, S2, E2); }
        sample_norm<1, 1>(a, fused_normp<0>(ws, a.out, ng), CW + CW_SAMPLE + 0, 8 * 11);
    }
    SEAM(2);
    if (IN(4)) { pg8::Gemm g{HB, WIN, D, D}; pg8::StaticOrder S; S.init(MT, DIN, G, blockIdx.x); pg8::EpiWin E{Qb, Kb, Vt, Vts, Sb, Bg, SA, SC, a.out, RS + 1 * MT, (const float*)(ws + WS_SS) + 0 * MT}; pg8::gemm_phase(lds, g, S, E);
        constexpr int NB = (MT / 256) * (DIN / 256) % 256;
        const int me = (int)blockIdx.x - NB, nw = G - NB;
        if (me >= 0) {
            LAS float* t = (LAS float*)lds; int job = 0;
            for (int b = 0; b < SB; ++b)
                tr_matrix(t, job, nw, me, a.in[I_CV] + (size_t)b * 512 * 512, 512, 512, 8, Vts + (size_t)b * 512 * SKV, SKV, ident);
            for (size_t i = (size_t)me * 512 + threadIdx.x; i < (size_t)SB * 512 * 512 / 8; i += (size_t)nw * 512) {
                const size_t e = i * 8; const int b = (int)(e >> 18), rem = (int)(e & 262143);
                const float* src = a.in[I_CK] + e;
                *(u32x4*)(Kb + ((size_t)MP + (size_t)b * SKV) * 512 + rem) = pg8::pack8(*(const f32x4*)src, *(const f32x4*)(src + 4));
            } } }
    SEAM(4);
    if (IN(5)) {
        const float* rb = a.in[I_RB];
        for (int u = blockIdx.x; u < NB * 8 * 32 + SB * 8; u += G) {
            if (u < NB * 8 * 32) { const int j = u & 31, h = (u >> 5) & 7, b = u >> 8;
                attn_unit(lds, Qb + ((size_t)b * SEQ + j * 256) * 512 + h * 64, ATT + ((size_t)b * SEQ + j * 256) * 512 + h * 64, Kb + (size_t)b * SEQ * 512 + h * 64,
                          Vt + ((size_t)b * 512 + h * 64) * SEQ, SEQ, rb + h * 257, 4 * j, 4, false);
            } else { const int us = u - NB * 8 * 32, h = us & 7, b = us >> 3;
                attn_unit(lds, Qb + ((size_t)MP + b * ST) * 512 + h * 64, ATT + ((size_t)MP + b * ST) * 512 + h * 64, Kb + ((size_t)MP + (size_t)b * SKV) * 512 + h * 64,
                          Vts + ((size_t)b * 512 + h * 64) * SKV, SKV, rb + h * 257, 8, 1, true);
            }
        }
        const float* cw = a.in[I_CW]; const float* cc = a.in[I_CC];
        constexpr int RG = 8;
        for (size_t i = (size_t)blockIdx.x * 512 + tid; i < (size_t)(MT / RG) * 64; i += (size_t)G * 512) {
            const int r0 = (int)(i >> 6) * RG, c = (int)(i & 63) * 8;
            int t0; const float* pre = nullptr;
            if (r0 < MP) t0 = r0 & 8191; else { const int rs = r0 - MP; t0 = rs & 15; pre = cc + (size_t)(rs >> 4) * 2 * 512; }
            f32x4 sa[RG + 2], sb[RG + 2], ba[RG], bb[RG];
#pragma unroll
            for (int k = 0; k < RG; ++k) { pg8::unpack8(*(const u32x4*)(Sb + (size_t)(r0 + k) * 512 + c), sa[k + 2], sb[k + 2]); pg8::unpack8(*(const u32x4*)(Bg + (size_t)(r0 + k) * 512 + c), ba[k], bb[k]); }
            if (t0 != 0) { pg8::unpack8(*(const u32x4*)(Sb + (size_t)(r0 - 2) * 512 + c), sa[0], sb[0]); pg8::unpack8(*(const u32x4*)(Sb + (size_t)(r0 - 1) * 512 + c), sa[1], sb[1]); }
            else if (pre) { sa[0] = *(const f32x4*)(pre + c); sb[0] = *(const f32x4*)(pre + c + 4); sa[1] = *(const f32x4*)(pre + 512 + c); sb[1] = *(const f32x4*)(pre + 512 + c + 4); }
            else { sa[0] = (f32x4){0.f, 0.f, 0.f, 0.f}; sb[0] = sa[0]; sa[1] = sa[0]; sb[1] = sa[0]; }
            const f32x4 w0a = *(const f32x4*)(cw + c), w0b = *(const f32x4*)(cw + c + 4), w1a = *(const f32x4*)(cw + 512 + c), w1b = *(const f32x4*)(cw + 512 + c + 4),
                        w2a = *(const f32x4*)(cw + 1024 + c), w2b = *(const f32x4*)(cw + 1024 + c + 4);
#pragma unroll
            for (int k = 0; k < RG; ++k) {
                const f32x4 ya = ba[k] * (sa[k] * w0a + sa[k + 1] * w1a + sa[k + 2] * w2a), yb = bb[k] * (sb[k] * w0b + sb[k + 1] * w1b + sb[k + 2] * w2b);
                *(u32x4*)(YC + (size_t)(r0 + k) * 512 + c) = pg8::pack8(ya, yb);
            }
        }
    }
    SEAM(5);
    if (IN(6)) {
        constexpr int NB6 = (MT / 256) * (D / 256) % 256;
        const int me6 = (int)blockIdx.x - NB6, nw6 = G - NB6;
        { pg8::Gemm g{ATT, WAO, DA, DA}; pg8::StaticOrder S; S.init(MT, D, G, blockIdx.x); pg8::EpiStd<1> E{MM, SA, D}; pg8::gemm_phase(lds, g, S, E); }
        if (me6 >= 0) { LAS float* t = (LAS float*)lds; int job = 0;
            tr_matrix(t, job, nw6, me6, a.in[I_W2G], FF, D, FF / 64, W2GU, D, gate, ng + 4 * D);
            tr_matrix(t, job, nw6, me6, a.in[I_W2U], FF, D, FF / 64, W2GU, D, up, ng + 4 * D); }
        { pg8::Gemm g{YC, WCO, DA, DA}; pg8::StaticOrder S; S.init(MT, D, G, blockIdx.x); pg8::EpiStd<2> E{MM, SC, D}; pg8::gemm_phase(lds, g, S, E); }
        if (me6 >= 0) { LAS float* t = (LAS float*)lds; int job = 0; tr_matrix(t, job, nw6, me6, a.in[I_W2D], D, FF, D / 64, W2D, FF, ident); }
    }
    SEAM(6);
    if (IN(7)) {
        { pg8::Gemm g{MM, WOUT, D, D}; pg8::StaticOrder S; S.init(MP, D, G, blockIdx.x);
          EpiX<1> E{ws, a.out, ng, lds}; pg8::gemm_phase(lds, g, S, E); }
        { const int id = blockIdx.x, ks = id % 4, t = id / 4;
          pg8::Gemm g2{MM + ks * (D / 4), WOUT + ks * (D / 4), D / 4, D}; pg8::OneUnit S2{MP / 256 + (t >> 2), t & 3, id < 8 * 4}; pg8::EpiPartial E2{FSP + (size_t)ks * MS * D}; pg8::gemm_phase(lds, g2, S2, E2); }
        sample_norm<1, 1>(a, fused_normp<1>(ws, a.out, ng), CW + CW_SAMPLE + 1, 8 * 4);
    }
    SEAM(7);
    if (IN(9)) { pg8::Gemm g{HB, W2GU, D, D}; pg8::StaticOrder S; S.init(MT, 2 * FF, G, blockIdx.x); pg8::EpiGateUp E{ACT, RS + 2 * MT, (const float*)(ws + WS_SS) + 1 * MT}; pg8::gemm_phase(lds, g, S, E);
        constexpr int NB = (MT / 256) * (2 * FF / 256) % 256;
        const int me = (int)blockIdx.x - NB, nw = G - NB;
        if (me >= 0) { LAS float* t = (LAS float*)lds; int job = 0;
            tr_matrix(t, job, nw, me, a.in[I_WPG], D, D, D / 64, WPG, D, ident);
            tr_matrix(t, job, nw, me, a.in[I_WPP], D, DPLE, D / 64, WPP, DPLE, ident);
            for (size_t i = (size_t)me * 512 + threadIdx.x; i < (size_t)MT * DPLE / 8; i += (size_t)nw * 512) {
                const size_t e = i * 8; const float* src = e < (size_t)MP * DPLE ? a.in[I_PP] + e : a.in[I_PS] + (e - (size_t)MP * DPLE);
                *(u32x4*)(PB + e) = pg8::pack8(*(const f32x4*)src, *(const f32x4*)(src + 4));
            } } }
    SEAM(9);
    if (IN(10)) {
        { pg8::Gemm g{ACT, W2D, FF, FF}; pg8::StaticOrder S; S.init(MP, D, G, blockIdx.x);
          EpiX<2> E{ws, a.out, ng, lds}; pg8::gemm_phase(lds, g, S, E); }
        { const int id = blockIdx.x, ks = id % 11, t = id / 11;
          pg8::Gemm g2{ACT + ks * (FF / 11), W2D + ks * (FF / 11), FF / 11, FF}; pg8::OneUnit S2{MP / 256 + (t >> 2), t & 3, id < 8 * 11}; pg8::EpiPartial E2{FSP + (size_t)ks * MS * D}; pg8::gemm_phase(lds, g2, S2, E2); }
        sample_norm<0, 2>(a, fused_normp<2>(ws, a.out, ng), CW + CW_SAMPLE + 2, 8 * 11);
    }
    SEAM(10);
    if (IN(12)) {
        const int id = blockIdx.x;
        { pg8::Gemm g{PB, WPP, DPLE, DPLE}; pg8::StaticOrder S; S.init(MP, D, G, blockIdx.x); pg8::EpiStd<0> E{F, nullptr, D}; pg8::gemm_phase(lds, g, S, E);
          pg8::OneUnit S2{MP / 256 + (id >> 2), id & 3, id < 8}; pg8::gemm_phase(lds, g, S2, E); }
        { pg8::Gemm g{AN, WPG, D, D}; pg8::StaticOrder S; S.init(MP, D, G, blockIdx.x);
          EpiX<3> E{ws, a.out, ng, lds}; pg8::gemm_phase(lds, g, S, E); }
        { const int ks = id % 4, t = id / 4;
          pg8::Gemm g2{AN + ks * (D / 4), WPG + ks * (D / 4), D / 4, D}; pg8::OneUnit S2{MP / 256 + (t >> 2), t & 3, id < 8 * 4}; pg8::EpiPartial E2{FSP + (size_t)ks * MS * D}; pg8::gemm_phase(lds, g2, S2, E2); }
        sample_norm<2, 0, true>(a, fused_normp<3>(ws, a.out, ng), CW + CW_SAMPLE + 3, 8 * 4);
    }
#undef IN
#undef SEAM
}

constexpr int N_PHASES = 14;
#ifndef ONE_LAUNCH
#define ONE_LAUNCH 1
#endif
extern "C" void kernel_launch(void* const* d_in, const int* in_sizes, int n_in, void* d_out, int out_size, void* d_ws, size_t ws_size, hipStream_t stream) {
    static int grid = 0;
    if (grid == 0) {
        if (n_in != 22 || (size_t)out_size != O_END || ws_size < WS_TOTAL) { fprintf(stderr, "kernel_launch: unexpected shapes (n_in %d out %d ws %zu need %zu)\n", n_in, out_size, ws_size, (size_t)WS_END); grid = -1; return; }
        int dev = 0, cus = 0, per_cu = 0;
        (void)hipGetDevice(&dev); (void)hipDeviceGetAttribute(&cus, hipDeviceAttributeMultiprocessorCount, dev);
        if (hipFuncSetAttribute((const void*)fwd_kernel, hipFuncAttributeMaxDynamicSharedMemorySize, LDS_BYTES) != hipSuccess) { fprintf(stderr, "kernel_launch: hipFuncSetAttribute failed\n"); grid = -1; return; }
        if (hipOccupancyMaxActiveBlocksPerMultiprocessor(&per_cu, (const void*)fwd_kernel, 512, LDS_BYTES) != hipSuccess || per_cu < 1) { fprintf(stderr, "kernel_launch: occupancy query gave %d\n", per_cu); per_cu = 1; }
        (void)hipGetLastError();
        grid = cus * per_cu;
    }
    if (grid < 0) return;
    Args a{};
    for (int i = 0; i < 22; ++i) a.in[i] = (const float*)d_in[i];
    a.out = (float*)d_out; a.ws = (unsigned char*)d_ws;
#if ONE_LAUNCH
    if (hipMemsetAsync((char*)d_ws + WS_CTL, 0, CTL_BYTES, stream) != hipSuccess) { fprintf(stderr, "kernel_launch: memset of the barrier words failed\n"); return; }
    a.ph_lo = 0; a.ph_hi = N_PHASES;
    void* args[] = {&a};
    hipError_t e = hipLaunchCooperativeKernel((const void*)fwd_kernel, dim3(grid), dim3(512), args, LDS_BYTES, stream);
    if (e != hipSuccess) fprintf(stderr, "cooperative launch failed: %s (grid %d)\n", hipGetErrorString(e), grid);
#else
    for (int p = 0; p < N_PHASES; ++p) { a.ph_lo = p; a.ph_hi = p + 1; hipLaunchKernelGGL(fwd_kernel, dim3(grid), dim3(512), LDS_BYTES, stream, a); }
#endif
}
```

```cpp
#include <hip/hip_runtime.h>
#include <hip/hip_cooperative_groups.h>
#include <cstdio>
#include <cstdint>
namespace cg = cooperative_groups;

#define LAS __attribute__((address_space(3)))
typedef unsigned short bf16_t;
typedef short bf16x8 __attribute__((ext_vector_type(8)));
typedef short s16x4 __attribute__((ext_vector_type(4)));
typedef float f32x4 __attribute__((ext_vector_type(4)));
typedef float f32x16 __attribute__((ext_vector_type(16)));
typedef unsigned u32x4 __attribute__((ext_vector_type(4)));
typedef unsigned u32x2 __attribute__((ext_vector_type(2)));

constexpr int MP = 65536, MS = 512, MT = MP + MS;
constexpr int D = 1024, FF = 2816, DIN = 5120, DA = 512, DPLE = 256;
constexpr int SEQ = 8192, NB = 8, SB = 32, ST = 16, SKV = 576;
constexpr int KROWS = MP + SB * SKV;
constexpr float EPS = 1e-6f;

constexpr size_t O_Y = 0;
constexpr size_t O_KP = (size_t)MT * D;
constexpr size_t O_VP = O_KP + (size_t)NB * 512 * 512;
constexpr size_t O_CP = O_VP + (size_t)NB * 512 * 512;
constexpr size_t O_KS = O_CP + (size_t)NB * 2 * 512;
constexpr size_t O_VS = O_KS + (size_t)SB * ST * 512;
constexpr size_t O_CS = O_VS + (size_t)SB * ST * 512;
constexpr size_t O_END = O_CS + (size_t)SB * 2 * 512;

constexpr size_t WS_W1GU = 0;
constexpr size_t WS_W1D  = WS_W1GU + (size_t)2 * FF * D * 2;
constexpr size_t WS_WIN  = WS_W1D + (size_t)D * FF * 2;
constexpr size_t WS_WAO  = WS_WIN + (size_t)DIN * D * 2;
constexpr size_t WS_WCO  = WS_WAO + (size_t)D * DA * 2;
constexpr size_t WS_WOUT = WS_WCO + (size_t)D * DA * 2;
constexpr size_t WS_W2GU = WS_WOUT + (size_t)D * D * 2;
constexpr size_t WS_W2D  = WS_W2GU + (size_t)2 * FF * D * 2;
constexpr size_t WS_WPG  = WS_W2D + (size_t)D * FF * 2;
constexpr size_t WS_WPP  = WS_WPG + (size_t)D * D * 2;
constexpr size_t WS_PB   = WS_WPP + (size_t)D * DPLE * 2;
constexpr size_t WS_AN   = WS_PB + (size_t)MT * DPLE * 2;
constexpr size_t WS_F    = WS_AN + (size_t)MT * D * 2;
constexpr size_t WS_BIG  = WS_F + (size_t)MT * D * 2;
constexpr size_t WS_ACT  = WS_BIG;
constexpr size_t WS_Q    = WS_BIG;
constexpr size_t WS_K    = WS_Q + (size_t)MT * 512 * 2;
constexpr size_t WS_VT   = WS_K + (size_t)KROWS * 512 * 2;
constexpr size_t WS_VTS  = WS_VT + (size_t)NB * 512 * SEQ * 2;
constexpr size_t WS_S    = WS_VTS + (size_t)SB * 512 * SKV * 2;
constexpr size_t WS_BG   = WS_S + (size_t)MT * 512 * 2;
constexpr size_t WS_SA   = WS_BG + (size_t)MT * 512 * 2;
constexpr size_t WS_SC   = WS_SA + (size_t)MT * D * 2;
constexpr size_t WS_END  = WS_SC + (size_t)MT * D * 2;
constexpr size_t WS_MM   = WS_Q;
constexpr size_t WS_ATT  = WS_F;
constexpr size_t WS_YC   = WS_F + (size_t)MT * 512 * 2;
static_assert(WS_ACT + (size_t)MT * FF * 2 <= WS_END, "act overlay");
static_assert(WS_MM + (size_t)MT * D * 2 <= WS_S, "mm overlay");
constexpr size_t WS_CTL = WS_END, CTL_WORDS_BYTES = 32768, SS_BYTES = (size_t)2 * MT * 4, CTL_BYTES = CTL_WORDS_BYTES + SS_BYTES;
constexpr size_t WS_SS = WS_CTL + CTL_WORDS_BYTES;
constexpr size_t WS_FS = WS_CTL + CTL_BYTES, FS_ONE = (size_t)MS * D * 4;
constexpr size_t WS_RS = WS_FS + 11 * FS_ONE;
constexpr size_t WS_X = WS_RS + (size_t)3 * MT * 4;
constexpr size_t WS_TOTAL = WS_X + (size_t)4 * 258 * 4 * 256 * 4;
static_assert(WS_TOTAL <= ((size_t)1 << 30), "workspace");

constexpr int LDS_BYTES = 131072 + 1024 + 4096 + 1024;

__device__ __forceinline__ unsigned cvt_pk_bf16(float lo, float hi) { unsigned r; asm volatile("v_cvt_pk_bf16_f32 %0, %1, %2" : "=v"(r) : "v"(lo), "v"(hi)); return r; }
__device__ __forceinline__ float bf_lo(unsigned u) { return __builtin_bit_cast(float, u << 16); }
__device__ __forceinline__ float bf_hi(unsigned u) { return __builtin_bit_cast(float, u & 0xffff0000u); }
__device__ __forceinline__ float sigmoidf_(float x) { return __builtin_amdgcn_rcpf(1.f + __expf(-x)); }
__device__ __forceinline__ float wave_sum(float v) {
#pragma unroll
    for (int o = 32; o >= 1; o >>= 1) v += __shfl_xor(v, o);
    return v;
}

namespace pg8 {
constexpr int BM = 256, BK = 64, HALF = 128, HTB = HALF * BK * 2, STAGE_BYTES = 8 * HTB, NXCD = 8, WGM = 4;
__host__ __device__ __forceinline__ int lds_byte(int r, int c) { const int st = (r >> 4) * 2 + (c >> 5), rr = r & 15, cc = c & 31, ob = rr * 64 + cc * 2; return st * 1024 + (ob ^ (((ob >> 9) & 1) << 5)); }
__host__ __device__ __forceinline__ void stage_rc(int b, int& R, int& C) { const int st = b / 1024, sb = b % 1024, swz = sb ^ (((sb >> 9) & 1) << 5); R = (st >> 1) * 16 + swz / 64; C = (st & 1) * 32 + (swz % 64) / 2; }
__host__ __device__ __forceinline__ int perm32(int rho) { const int n = rho >> 4, i = rho & 15; return 8 * (i >> 2) + 4 * n + (i & 3); }

struct Unit { int pm, pn; };
struct Gemm { const bf16_t* A; const bf16_t* Bt; int K, ld; };

struct StaticOrder {
    int nM, nN, nwg, G, c;
    __host__ __device__ void init(int M, int N, int G_, int c_) { nM = M / BM; nN = N / BM; nwg = nM * nN; G = G_; c = c_; }
    __host__ __device__ bool next(int i, Unit& u) const {
        const long L = (long)i * G + c; if (L >= nwg) return false;
        int wgid = (int)L; { const int q = nwg / NXCD, r = nwg % NXCD, xcd = wgid % NXCD, off = wgid / NXCD; wgid = (xcd < r ? xcd * (q + 1) : r * (q + 1) + (xcd - r) * q) + off; }
        const int nig = WGM * nN, gid = wgid / nig, fm = gid * WGM, gsz = (nM - fm) < WGM ? (nM - fm) : WGM;
        u.pm = fm + ((wgid % nig) % gsz); u.pn = (wgid % nig) / gsz; return true;
    }
};

template <class Epi, class Sched>
__device__ __forceinline__ void gemm_phase(LAS unsigned char* lds, const Gemm g, const Sched& S, const Epi& E) {
    int tid_ = threadIdx.x; asm volatile("" : "+v"(tid_));
    const int tid = tid_, wid = __builtin_amdgcn_readfirstlane(tid >> 6), lane = tid & 63, wr = wid >> 2, wc = wid & 3, fr = lane & 15, fq = lane >> 4;
    const int K = g.K, ld = g.ld, nt = K / BK;
    unsigned voffA[2], voffB[2];
#pragma unroll
    for (int i = 0; i < 2; ++i) { int R, C; stage_rc(tid * 16 + i * 8192, R, C); const int Rb = (R & ~31) + perm32(R & 31);
        voffA[i] = (unsigned)(R * ld + C) * 2u; voffB[i] = (unsigned)(Rb * ld + C) * 2u; }
    const size_t kstep = (size_t)(BK * 2);
    const size_t hstep = (size_t)HALF * ld * 2;
    const size_t tstep = 2 * hstep;
    const unsigned ldsw = (unsigned)wid * 1024u;
    const int aoff = lds_byte(wr * 64 + fr, fq * 8), boff = lds_byte(wc * 32 + fr, fq * 8);
#define PG8_SA(b, h) (((b) * 2 + (h)) * HTB)
#define PG8_SB(b, h) ((4 + (b) * 2 + (h)) * HTB)
#define PG8_STAGE(bufoff, gbase, voff) do { _Pragma("unroll") for (int _i = 0; _i < 2; ++_i) \
        __builtin_amdgcn_global_load_lds((const unsigned*)((const char*)(gbase) + (voff)[_i]), (LAS unsigned*)(lds + (bufoff) + ldsw + _i * 8192), 16, 0, 0); } while (0)
#define PG8_LDA(dst, b, h) do { _Pragma("unroll") for (int m = 0; m < 4; ++m) _Pragma("unroll") for (int k = 0; k < 2; ++k) dst[m][k] = *(const LAS bf16x8*)(lds + PG8_SA(b, h) + aoff + m * 2048 + k * 1024); } while (0)
#define PG8_LDB(dst, b, h) do { _Pragma("unroll") for (int n = 0; n < 2; ++n) _Pragma("unroll") for (int k = 0; k < 2; ++k) dst[n][k] = *(const LAS bf16x8*)(lds + PG8_SB(b, h) + boff + n * 2048 + k * 1024); } while (0)
#define PG8_MMA(ai, bj, At, Bt) do { __builtin_amdgcn_s_setprio(1); _Pragma("unroll") for (int m = 0; m < 4; ++m) _Pragma("unroll") for (int n = 0; n < 2; ++n) _Pragma("unroll") for (int k = 0; k < 2; ++k) \
        acc[ai][bj][m][n] = __builtin_amdgcn_mfma_f32_16x16x32_bf16(Bt[n][k], At[m][k], acc[ai][bj][m][n], 0, 0, 0); __builtin_amdgcn_s_setprio(0); } while (0)
#define PG8_WAIT_V(n) asm volatile("s_waitcnt vmcnt(" #n ")" ::: "memory")
#define PG8_WAIT_L(n) asm volatile("s_waitcnt lgkmcnt(" #n ")" ::: "memory")
#define PG8_BAR __builtin_amdgcn_s_barrier()
#define PG8_SCHED __builtin_amdgcn_sched_barrier(0)
    Unit cur, nxt; int ui = 0;
    if (!S.next(0, cur)) return;
    f32x4 acc[2][2][4][2];
#pragma unroll
    for (int a = 0; a < 2; ++a)
#pragma unroll
        for (int b = 0; b < 2; ++b)
#pragma unroll
            for (int m = 0; m < 4; ++m)
#pragma unroll
                for (int n = 0; n < 2; ++n) acc[a][b][m][n] = (f32x4){0.f, 0.f, 0.f, 0.f};
    bf16x8 At[4][2], B0[2][2], B1[2][2];
    const char* cA = (const char*)g.A + (size_t)cur.pm * tstep; const char* cB = (const char*)g.Bt + (size_t)cur.pn * tstep;
    PG8_STAGE(PG8_SB(0, 0), cB, voffB); PG8_STAGE(PG8_SB(0, 1), cB + hstep, voffB); PG8_STAGE(PG8_SA(0, 0), cA, voffA); PG8_STAGE(PG8_SA(0, 1), cA + hstep, voffA);
    if (wr == 1) PG8_BAR;
    PG8_WAIT_V(2); PG8_BAR;
    PG8_STAGE(PG8_SB(1, 0), cB + kstep, voffB); PG8_STAGE(PG8_SA(1, 0), cA + kstep, voffA); PG8_STAGE(PG8_SB(1, 1), cB + hstep + kstep, voffB);
    PG8_WAIT_V(6); PG8_BAR;
    for (;;) {
        const bool has_next = S.next(ui + 1, nxt);
        const char* nA = has_next ? (const char*)g.A + (size_t)nxt.pm * tstep : cA; const char* nB = has_next ? (const char*)g.Bt + (size_t)nxt.pn * tstep : cB;
        for (int t = 0; t < nt; t += 2) {
            const bool last = (t == nt - 2);
            const char* a1 = cA + (size_t)(t + 1) * kstep;
            const char* a2 = last ? nA : cA + (size_t)(t + 2) * kstep; const char* b2 = last ? nB : cB + (size_t)(t + 2) * kstep;
            const char* a3 = a2 + kstep; const char* b3 = b2 + kstep;
            PG8_LDB(B0, 0, 0); PG8_LDB(B1, 0, 1); PG8_SCHED; PG8_LDA(At, 0, 0); PG8_STAGE(PG8_SA(1, 1), a1 + hstep, voffA);
            PG8_WAIT_V(8); PG8_WAIT_L(0); PG8_BAR; PG8_MMA(0, 0, At, B0); PG8_MMA(0, 1, At, B1); PG8_BAR; PG8_SCHED;
            PG8_LDA(At, 0, 1); PG8_STAGE(PG8_SB(0, 0), b2, voffB); PG8_STAGE(PG8_SB(0, 1), b2 + hstep, voffB); PG8_STAGE(PG8_SA(0, 0), a2, voffA);
            PG8_WAIT_V(8); PG8_WAIT_L(0); PG8_BAR; PG8_MMA(1, 0, At, B0); PG8_MMA(1, 1, At, B1); PG8_BAR; PG8_SCHED;
            PG8_LDB(B0, 1, 0); PG8_LDB(B1, 1, 1); PG8_SCHED; PG8_LDA(At, 1, 0); PG8_STAGE(PG8_SA(0, 1), a2 + hstep, voffA);
            PG8_WAIT_V(8); PG8_WAIT_L(0); PG8_BAR; PG8_MMA(0, 0, At, B0); PG8_MMA(0, 1, At, B1); PG8_BAR; PG8_SCHED;
            PG8_LDA(At, 1, 1); PG8_STAGE(PG8_SB(1, 0), b3, voffB); PG8_STAGE(PG8_SB(1, 1), b3 + hstep, voffB); PG8_STAGE(PG8_SA(1, 0), a3, voffA);
            PG8_WAIT_V(8); PG8_WAIT_L(0); PG8_BAR; PG8_MMA(1, 0, At, B0); PG8_MMA(1, 1, At, B1); PG8_BAR; PG8_SCHED;
        }
        if (wr == 0) PG8_BAR;
        E(acc, cur, wr, wc, fr, fq);
        if (!has_next) break;
#pragma unroll
        for (int a = 0; a < 2; ++a)
#pragma unroll
            for (int b = 0; b < 2; ++b)
#pragma unroll
                for (int m = 0; m < 4; ++m)
#pragma unroll
                    for (int n = 0; n < 2; ++n) acc[a][b][m][n] = (f32x4){0.f, 0.f, 0.f, 0.f};
        cur = nxt; cA = nA; cB = nB; ++ui;
        if (wr == 1) PG8_BAR;
    }
    PG8_WAIT_V(0);
    PG8_BAR;
#undef PG8_SA
#undef PG8_SB
#undef PG8_STAGE
#undef PG8_LDA
#undef PG8_LDB
#undef PG8_MMA
#undef PG8_WAIT_V
#undef PG8_WAIT_L
#undef PG8_BAR
#undef PG8_SCHED
}

typedef f32x4 Acc[2][2][4][2];
struct OneUnit { int pm, pn; bool valid;
    __device__ __forceinline__ bool next(int i, Unit& u) const { if (i != 0 || !valid) return false; u.pm = pm; u.pn = pn; return true; } };

__device__ __forceinline__ u32x4 pack8(const f32x4 a, const f32x4 b) {
    u32x4 w; w.x = cvt_pk_bf16(a[0], a[1]); w.y = cvt_pk_bf16(a[2], a[3]); w.z = cvt_pk_bf16(b[0], b[1]); w.w = cvt_pk_bf16(b[2], b[3]); return w;
}
__device__ __forceinline__ void unpack8(const u32x4 w, f32x4& a, f32x4& b) {
    a = (f32x4){bf_lo(w.x), bf_hi(w.x), bf_lo(w.y), bf_hi(w.y)}; b = (f32x4){bf_lo(w.z), bf_hi(w.z), bf_lo(w.w), bf_hi(w.w)};
}

template <int MODE> struct EpiStd {
    bf16_t* O; const bf16_t* G; int ldc;
    __device__ __forceinline__ void operator()(const Acc& acc, const Unit& u, int wr, int wc, int fr, int fq) const {
        const int row0 = u.pm * BM + wr * 64 + fr, col0 = u.pn * BM + wc * 32 + 8 * fq;
#pragma unroll
        for (int ai = 0; ai < 2; ++ai)
#pragma unroll
            for (int m = 0; m < 4; ++m) {
                const size_t ro = (size_t)(row0 + ai * HALF + m * 16) * ldc + col0;
#pragma unroll
                for (int bj = 0; bj < 2; ++bj) {
                    f32x4 v0 = acc[ai][bj][m][0], v1 = acc[ai][bj][m][1];
                    if (MODE == 1 || MODE == 2) { f32x4 g0, g1; unpack8(*(const u32x4*)(G + ro + bj * HALF), g0, g1); v0 = v0 * g0; v1 = v1 * g1; }
                    if (MODE == 2) { f32x4 o0, o1; unpack8(*(const u32x4*)(O + ro + bj * HALF), o0, o1); v0 = v0 + o0; v1 = v1 + o1; }
                    if (MODE == 3) { f32x4 o0, o1; unpack8(*(const u32x4*)(O + ro + bj * HALF), o0, o1);
#pragma unroll
                        for (int i = 0; i < 4; ++i) { v0[i] = sigmoidf_(v0[i]) * o0[i]; v1[i] = sigmoidf_(v1[i]) * o1[i]; } }
                    *(u32x4*)(O + ro + bj * HALF) = pack8(v0, v1);
                }
            }
    }
};

struct EpiPartial {
    float* FS;
    __device__ __forceinline__ void operator()(const Acc& acc, const Unit& u, int wr, int wc, int fr, int fq) const {
        const int row0 = (u.pm - MP / BM) * BM + wr * 64 + fr, col0 = u.pn * BM + wc * 32 + 8 * fq;
#pragma unroll
        for (int ai = 0; ai < 2; ++ai)
#pragma unroll
            for (int m = 0; m < 4; ++m) {
                float* p = FS + (size_t)(row0 + ai * HALF + m * 16) * D + col0;
#pragma unroll
                for (int bj = 0; bj < 2; ++bj) { *(f32x4*)(p + bj * HALF) = acc[ai][bj][m][0]; *(f32x4*)(p + bj * HALF + 4) = acc[ai][bj][m][1]; }
            }
    }
};

struct EpiGateUp {
    bf16_t* O; const float* rs; const float* ss;
    __device__ __forceinline__ void operator()(const Acc& acc, const Unit& u, int wr, int wc, int fr, int fq) const {
        const int row0 = u.pm * BM + wr * 64 + fr, col0 = u.pn * HALF + wc * 32 + 8 * fq;
#pragma unroll
        for (int ai = 0; ai < 2; ++ai)
#pragma unroll
            for (int m = 0; m < 4; ++m) {
                f32x4 v0, v1; const int rrow = row0 + ai * HALF + m * 16; const float rr = (ss != nullptr && u.pm < MP / BM) ? __builtin_amdgcn_rsqf(ss[rrow] * (1.f / D) + EPS) : rs[rrow];
#pragma unroll
                for (int i = 0; i < 4; ++i) { const float g0 = acc[ai][0][m][0][i] * rr, g1 = acc[ai][0][m][1][i] * rr;
                    v0[i] = g0 * sigmoidf_(g0) * (acc[ai][1][m][0][i] * rr); v1[i] = g1 * sigmoidf_(g1) * (acc[ai][1][m][1][i] * rr); }
                *(u32x4*)(O + (size_t)(row0 + ai * HALF + m * 16) * FF + col0) = pack8(v0, v1);
            }
    }
};

struct EpiWin {
    bf16_t *Q, *Kb, *Vt, *Vts, *Sb, *Bg, *SA, *SC; float* out; const float* rstd_; const float* ss;
    __device__ __forceinline__ float rstd_of(int r) const { return r < MP ? __builtin_amdgcn_rsqf(ss[r] * (1.f / D) + EPS) : rstd_[r]; }
    __device__ __forceinline__ void operator()(const Acc& acc, const Unit& u, int wr, int wc, int fr, int fq) const {
        const int pn = u.pn, pm = u.pm;
        const int row0 = pm * BM + wr * 64 + fr, cl0 = wc * 32 + 8 * fq;
        const bool samp = pm >= MP / BM;
        if (pn < 2 || pn >= 10) {
            bf16_t* base; int ldc, colt; float sc = 1.f; bool sg = false;
            if (pn < 2) { base = Q; ldc = 512; colt = pn * 256; sc = 0.125f * 1.4426950408889634f; }
            else if (pn < 12) { base = Bg; ldc = 512; colt = (pn - 10) * 256; }
            else if (pn < 16) { base = SA; ldc = 1024; colt = (pn - 12) * 256; sg = true; }
            else { base = SC; ldc = 1024; colt = (pn - 16) * 256; sg = true; }
#pragma unroll
            for (int ai = 0; ai < 2; ++ai)
#pragma unroll
                for (int m = 0; m < 4; ++m) {
                    const size_t ro = (size_t)(row0 + ai * HALF + m * 16) * ldc + colt + cl0; const float rr = sc * rstd_of(row0 + ai * HALF + m * 16);
#pragma unroll
                    for (int bj = 0; bj < 2; ++bj) {
                        f32x4 v0 = acc[ai][bj][m][0] * rr, v1 = acc[ai][bj][m][1] * rr;
                        if (sg) {
#pragma unroll
                            for (int i = 0; i < 4; ++i) { v0[i] = sigmoidf_(v0[i]); v1[i] = sigmoidf_(v1[i]); } }
                        *(u32x4*)(base + ro + bj * HALF) = pack8(v0, v1);
                    }
                }
        } else if (pn < 4) {
            const int colt = (pn - 2) * 256 + cl0;
            const bool wout = samp || ((pm & 31) >= 30);
#pragma unroll
            for (int ai = 0; ai < 2; ++ai)
#pragma unroll
                for (int m = 0; m < 4; ++m) {
                    const int r = row0 + ai * HALF + m * 16;
                    size_t krow, orow;
                    if (samp) { const int rs = r - MP; krow = (size_t)MP + (size_t)(rs >> 4) * SKV + 512 + (rs & 15); orow = O_KS + (size_t)rs * 512; }
                    else { krow = r; orow = O_KP + ((size_t)(r >> 13) * 512 + ((r & 8191) - 7680)) * 512; }
                    const float rr = rstd_of(r);
#pragma unroll
                    for (int bj = 0; bj < 2; ++bj) {
                        const f32x4 v0 = acc[ai][bj][m][0] * rr, v1 = acc[ai][bj][m][1] * rr;
                        *(u32x4*)(Kb + krow * 512 + colt + bj * HALF) = pack8(v0, v1);
                        if (wout) { *(f32x4*)(out + orow + colt + bj * HALF) = v0; *(f32x4*)(out + orow + colt + bj * HALF + 4) = v1; }
                    }
                }
        } else if (pn < 6) {
            const int colt = (pn - 4) * 256 + cl0;
            const bool wout = samp || ((pm & 31) >= 30);
#pragma unroll
            for (int ai = 0; ai < 2; ++ai)
#pragma unroll
                for (int m = 0; m < 4; ++m) {
                    const int r = row0 + ai * HALF + m * 16;
                    bf16_t* vb; size_t pitch, orow;
                    if (samp) { const int rs = r - MP; vb = Vts + (size_t)(rs >> 4) * 512 * SKV + 512 + (rs & 15); pitch = SKV; orow = O_VS + (size_t)rs * 512; }
                    else { vb = Vt + (size_t)(r >> 13) * 512 * SEQ + (r & 8191); pitch = SEQ; orow = O_VP + ((size_t)(r >> 13) * 512 + ((r & 8191) - 7680)) * 512; }
                    const float rr = rstd_of(r);
#pragma unroll
                    for (int bj = 0; bj < 2; ++bj) {
#pragma unroll
                        for (int n = 0; n < 2; ++n) {
                            const f32x4 vv = acc[ai][bj][m][n] * rr;
                            const unsigned p0 = cvt_pk_bf16(vv[0], vv[1]), p1 = cvt_pk_bf16(vv[2], vv[3]);
                            bf16_t* vp = vb + (size_t)(colt + bj * HALF + 4 * n) * pitch;
                            vp[0] = (bf16_t)(p0 & 0xffffu); vp[pitch] = (bf16_t)(p0 >> 16); vp[2 * pitch] = (bf16_t)(p1 & 0xffffu); vp[3 * pitch] = (bf16_t)(p1 >> 16);
                        }
                        if (wout) { *(f32x4*)(out + orow + colt + bj * HALF) = acc[ai][bj][m][0] * rr; *(f32x4*)(out + orow + colt + bj * HALF + 4) = acc[ai][bj][m][1] * rr; }
                    }
                }
        } else {
            const int colt = (pn - 6) * 128 + cl0;
#pragma unroll
            for (int ai = 0; ai < 2; ++ai)
#pragma unroll
                for (int m = 0; m < 4; ++m) {
                    const int r = row0 + ai * HALF + m * 16;
                    const float rr = rstd_of(r), rr2 = rr * rr;
                    const f32x4 v0 = acc[ai][0][m][0] * acc[ai][1][m][0] * rr2, v1 = acc[ai][0][m][1] * acc[ai][1][m][1] * rr2;
                    *(u32x4*)(Sb + (size_t)r * 512 + colt) = pack8(v0, v1);
                    if (samp) { const int rs = r - MP; if ((rs & 15) >= 14) { float* o = out + O_CS + ((size_t)(rs >> 4) * 2 + ((rs & 15) - 14)) * 512 + colt; *(f32x4*)o = v0; *(f32x4*)(o + 4) = v1; } }
                    else if ((r & 8191) >= 8190) { float* o = out + O_CP + ((size_t)(r >> 13) * 2 + ((r & 8191) - 8190)) * 512 + colt; *(f32x4*)o = v0; *(f32x4*)(o + 4) = v1; }
                }
        }
    }
};
}

struct Args { const float* in[22]; float* out; unsigned char* ws; int ph_lo, ph_hi; };
enum { I_XP = 0, I_XS, I_CK, I_CV, I_CC, I_PP, I_PS, I_NG, I_W1G, I_W1U, I_W1D, I_WIN, I_CW, I_RB, I_WAO, I_WCO, I_WOUT, I_W2G, I_W2U, I_W2D, I_WPG, I_WPP };

__device__ __forceinline__ void tr_tile(LAS float* t, const float* src, int ldS, int k0, int c0, bf16_t* dst, int ldD, int r0, const float* gk) {
    const int tid = threadIdx.x, ty = tid >> 4, tx = tid & 15;
#pragma unroll
    for (int i = 0; i < 2; ++i) { const int k = ty + 32 * i; f32x4 v = *(const f32x4*)(src + (size_t)(k0 + k) * ldS + c0 + 4 * tx); if (gk) v = v * gk[k0 + k];
        t[k * 65 + 4 * tx + 0] = v[0]; t[k * 65 + 4 * tx + 1] = v[1]; t[k * 65 + 4 * tx + 2] = v[2]; t[k * 65 + 4 * tx + 3] = v[3]; }
    __syncthreads();
    const int c = tid >> 3, kk = (tid & 7) * 8;
    u32x4 w;
    w.x = cvt_pk_bf16(t[(kk + 0) * 65 + c], t[(kk + 1) * 65 + c]); w.y = cvt_pk_bf16(t[(kk + 2) * 65 + c], t[(kk + 3) * 65 + c]);
    w.z = cvt_pk_bf16(t[(kk + 4) * 65 + c], t[(kk + 5) * 65 + c]); w.w = cvt_pk_bf16(t[(kk + 6) * 65 + c], t[(kk + 7) * 65 + c]);
    *(u32x4*)(dst + (size_t)(r0 + c) * ldD + k0 + kk) = w;
    __syncthreads();
}

template <class CMap>
__device__ __forceinline__ void tr_matrix(LAS float* t, int& job, int nw, int me, const float* src, int ldS, int K, int ncb, bf16_t* dst, int ldD, const CMap& cmap, const float* gk = nullptr) {
    const int nkb = K / 64, ntile = nkb * ncb;
    int first = (me - job % nw + nw) % nw;
    for (int i = first; i < ntile; i += nw) { const int cb = i / nkb, kb = i % nkb; int c0, r0; cmap(cb, c0, r0); tr_tile(t, src, ldS, kb * 64, c0, dst, ldD, r0, gk); }
    job += ntile;
}

struct NormP { const bf16_t* F; const float* FS; int nsplit; const bf16_t* hb_in; bf16_t* hb_out; float* fout; const float* gpost; float alpha; float* rs; bf16_t* AN; };
template <int HIN>
__device__ __forceinline__ void norm_load_h(const Args& a, const NormP& p, int r, int lane, f32x4 (&h)[4]) {
    if (HIN == 0) { const float* hin = r < MP ? a.in[I_XP] + (size_t)r * D : a.in[I_XS] + (size_t)(r - MP) * D;
#pragma unroll
        for (int i = 0; i < 4; ++i) h[i] = __builtin_nontemporal_load((const f32x4*)(hin + 256 * i + 4 * lane)); }
    else {
#pragma unroll
        for (int i = 0; i < 4; ++i) { const u32x2 w = __builtin_nontemporal_load((const u32x2*)(p.hb_in + (size_t)r * D + 256 * i + 4 * lane)); h[i] = (f32x4){bf_lo(w.x), bf_hi(w.x), bf_lo(w.y), bf_hi(w.y)}; } }
}
template <bool HAS_F, int OUTH, int ANM>
__device__ __forceinline__ void norm_finish(const NormP& p, int r, int lane, f32x4 (&h)[4], const f32x4 (&f)[4]) {
    if (HAS_F) {
        float ss = 0.f;
#pragma unroll
        for (int i = 0; i < 4; ++i) ss += f[i][0] * f[i][0] + f[i][1] * f[i][1] + f[i][2] * f[i][2] + f[i][3] * f[i][3];
        ss = wave_sum(ss);
        const float rs = p.alpha * __builtin_amdgcn_rsqf(ss * (1.f / D) + EPS);
#pragma unroll
        for (int i = 0; i < 4; ++i) { const f32x4 g = *(const f32x4*)(p.gpost + 256 * i + 4 * lane); h[i] = h[i] + f[i] * g * rs; }
    }
    if (OUTH == 2) {
#pragma unroll
        for (int i = 0; i < 4; ++i) __builtin_nontemporal_store(h[i], (f32x4*)(p.fout + (size_t)r * D + 256 * i + 4 * lane));
    }
    if (OUTH == 1) {
#pragma unroll
        for (int i = 0; i < 4; ++i) { u32x2 w; w.x = cvt_pk_bf16(h[i][0], h[i][1]); w.y = cvt_pk_bf16(h[i][2], h[i][3]); __builtin_nontemporal_store(w, (u32x2*)(p.hb_out + (size_t)r * D + 256 * i + 4 * lane)); }
    }
    if (ANM == 1) {
        float ss = 0.f;
#pragma unroll
        for (int i = 0; i < 4; ++i) ss += h[i][0] * h[i][0] + h[i][1] * h[i][1] + h[i][2] * h[i][2] + h[i][3] * h[i][3];
        ss = wave_sum(ss);
        if (lane == 0) p.rs[r] = __builtin_amdgcn_rsqf(ss * (1.f / D) + EPS);
    }
    if (ANM == 2) {
#pragma unroll
        for (int i = 0; i < 4; ++i) { u32x2 w; w.x = cvt_pk_bf16(h[i][0], h[i][1]); w.y = cvt_pk_bf16(h[i][2], h[i][3]); *(u32x2*)(p.AN + (size_t)r * D + 256 * i + 4 * lane) = w; }
    }
}
template <int HIN, bool HAS_F, int OUTH, int ANM>
__device__ __forceinline__ void norm_rows(const Args& a, const NormP p) {
    const int lane = threadIdx.x & 63, wv = threadIdx.x >> 6, G = gridDim.x;
    constexpr int NR = 8;
    const int rows_main = p.FS ? MP : MT;
    for (int rb = blockIdx.x * 8 + wv; rb < rows_main; rb += G * 8 * NR) {
        int rj[NR]; bool vj[NR];
#pragma unroll
        for (int j = 0; j < NR; ++j) { vj[j] = rb + j * G * 8 < rows_main; rj[j] = vj[j] ? rb + j * G * 8 : rb; }
        f32x4 h[NR][4], f[NR][4];
#pragma unroll
        for (int j = 0; j < NR; ++j) { const int r = rj[j];
            norm_load_h<HIN>(a, p, r, lane, h[j]);
            if (HAS_F) {
#pragma unroll
                for (int i = 0; i < 4; ++i) { const u32x2 w = __builtin_nontemporal_load((const u32x2*)(p.F + (size_t)r * D + 256 * i + 4 * lane)); f[j][i] = (f32x4){bf_lo(w.x), bf_hi(w.x), bf_lo(w.y), bf_hi(w.y)}; }
            }
        }
#pragma unroll
        for (int j = 0; j < NR; ++j) if (vj[j]) norm_finish<HAS_F, OUTH, ANM>(p, rj[j], lane, h[j], f[j]);
    }
    if (HAS_F && p.FS) {
        for (int r = MP + blockIdx.x * 8 + wv; r < MT; r += G * 8) {
            f32x4 h[4], f[4];
            norm_load_h<HIN>(a, p, r, lane, h);
#pragma unroll
            for (int i = 0; i < 4; ++i) { f32x4 v = *(const f32x4*)(p.FS + (size_t)(r - MP) * D + 256 * i + 4 * lane);
                for (int k = 1; k < p.nsplit; ++k) v = v + *(const f32x4*)(p.FS + ((size_t)k * MS + (r - MP)) * D + 256 * i + 4 * lane);
                f[i] = v; }
            norm_finish<HAS_F, OUTH, ANM>(p, r, lane, h, f);
        }
    }
}

constexpr int CW_PANEL = 4096, CW_PANEL_STRIDE = 512, CW_SAMPLE = CW_PANEL + 4 * CW_PANEL_STRIDE;
__device__ __forceinline__ unsigned cw_ld(unsigned* p)              { return __hip_atomic_load(p, __ATOMIC_RELAXED, __HIP_MEMORY_SCOPE_AGENT); }
__device__ __forceinline__ unsigned cw_add(unsigned* p, unsigned v) { return __hip_atomic_fetch_add(p, v, __ATOMIC_RELAXED, __HIP_MEMORY_SCOPE_AGENT); }
__device__ __forceinline__ void arrive_and_wait(unsigned* cnt, unsigned need, bool arrive, bool wait) {
    asm volatile("s_waitcnt vmcnt(0)" ::: "memory");
    __syncthreads();
    if (threadIdx.x == 0) {
        if (arrive) { __builtin_amdgcn_fence(__ATOMIC_RELEASE, "agent"); asm volatile("s_waitcnt vmcnt(0)" ::: "memory"); (void)cw_add(cnt, 1u); }
        if (wait) { unsigned sp = 0; while (cw_ld(cnt) < need) { __builtin_amdgcn_s_sleep(1); if (++sp > (1u << 24)) break; }
            __builtin_amdgcn_fence(__ATOMIC_ACQUIRE, "agent"); asm volatile("s_waitcnt vmcnt(0)" ::: "memory"); }
    }
    __syncthreads();
}

template <int PH>
struct EpiX {
    unsigned char* ws; float* out; const float* ng; LAS unsigned char* lds;
    __device__ __forceinline__ void operator()(f32x4 (&acc)[2][2][4][2], const pg8::Unit& u, int wr, int wc, int fr, int fq) const {
        using namespace pg8;
        const int tid = threadIdx.x;
        LAS float* lpart = (LAS float*)(lds + 131072 + 1024);
        LAS float* lrs = lpart + 1024;
        const float* gpost = ng + (PH == 0 ? 1 : PH == 1 ? 3 : PH == 2 ? 5 : 6) * D;
        const float alpha = (PH == 0 || PH == 2) ? 0.5f : 1.f;
        const bf16_t* hin = PH == 3 ? (const bf16_t*)(ws + WS_AN) : (const bf16_t*)out;
        const int rloc0 = wr * 64 + fr, col0 = u.pn * BM + wc * 32 + 8 * fq;
        if (PH == 3) {
            const bf16_t* P = (const bf16_t*)(ws + WS_F);
#pragma unroll
            for (int ai = 0; ai < 2; ++ai)
#pragma unroll
                for (int m = 0; m < 4; ++m) { const size_t ro = (size_t)(u.pm * BM + rloc0 + ai * HALF + m * 16) * D + col0;
#pragma unroll
                    for (int bj = 0; bj < 2; ++bj) { f32x4 p0, p1; unpack8(*(const u32x4*)(P + ro + bj * HALF), p0, p1);
#pragma unroll
                        for (int i = 0; i < 4; ++i) { acc[ai][bj][m][0][i] = sigmoidf_(acc[ai][bj][m][0][i]) * p0[i]; acc[ai][bj][m][1][i] = sigmoidf_(acc[ai][bj][m][1][i]) * p1[i]; } } }
        }
#pragma unroll
        for (int ai = 0; ai < 2; ++ai)
#pragma unroll
            for (int m = 0; m < 4; ++m) {
                float sq = 0.f;
#pragma unroll
                for (int bj = 0; bj < 2; ++bj)
#pragma unroll
                    for (int n = 0; n < 2; ++n)
#pragma unroll
                        for (int i = 0; i < 4; ++i) sq += acc[ai][bj][m][n][i] * acc[ai][bj][m][n][i];
                sq += __shfl_xor(sq, 16); sq += __shfl_xor(sq, 32);
                if (fq == 0) lpart[wc * 256 + rloc0 + ai * HALF + m * 16] = sq;
            }
        __syncthreads();
        float* X = (float*)(ws + WS_X) + ((size_t)(PH * 258 + u.pm) * 4) * 256;
        if (tid < 256) __hip_atomic_store(X + u.pn * 256 + tid, lpart[tid] + lpart[256 + tid] + lpart[512 + tid] + lpart[768 + tid], __ATOMIC_RELAXED, __HIP_MEMORY_SCOPE_AGENT);
        asm volatile("s_waitcnt vmcnt(0)" ::: "memory");
        __syncthreads();
        if (tid == 0) { unsigned* cnt = (unsigned*)(ws + WS_CTL) + CW_PANEL + PH * CW_PANEL_STRIDE + u.pm; (void)cw_add(cnt, 1u);
            unsigned sp = 0; while (cw_ld(cnt) < 4u) { __builtin_amdgcn_s_sleep(1); if (++sp > (1u << 24)) break; } }
        __syncthreads();
        if (tid < 256) { float tot = 0.f;
#pragma unroll
            for (int q = 0; q < 4; ++q) tot += __hip_atomic_load(X + q * 256 + tid, __ATOMIC_RELAXED, __HIP_MEMORY_SCOPE_AGENT);
            lrs[tid] = alpha * __builtin_amdgcn_rsqf(tot * (1.f / D) + EPS); }
        __syncthreads();
        f32x4 g[2][2];
#pragma unroll
        for (int bj = 0; bj < 2; ++bj) { g[bj][0] = *(const f32x4*)(gpost + col0 + bj * HALF); g[bj][1] = *(const f32x4*)(gpost + col0 + bj * HALF + 4); }
#pragma unroll
        for (int ai = 0; ai < 2; ++ai)
#pragma unroll
            for (int m = 0; m < 4; ++m) {
                const int rloc = rloc0 + ai * HALF + m * 16; const float rs = lrs[rloc];
                const size_t ro = (size_t)(u.pm * BM + rloc) * D + col0;
                float sq = 0.f;
#pragma unroll
                for (int bj = 0; bj < 2; ++bj) {
                    f32x4 h0, h1; unpack8(*(const u32x4*)(hin + ro + bj * HALF), h0, h1);
                    h0 = h0 + acc[ai][bj][m][0] * g[bj][0] * rs; h1 = h1 + acc[ai][bj][m][1] * g[bj][1] * rs;
                    if (PH < 2) { const u32x4 w = pack8(h0, h1); *(u32x4*)((bf16_t*)out + ro + bj * HALF) = w; f32x4 r0, r1; unpack8(w, r0, r1);
#pragma unroll
                        for (int i = 0; i < 4; ++i) sq += r0[i] * r0[i] + r1[i] * r1[i]; }
                    if (PH == 2) *(u32x4*)((bf16_t*)(ws + WS_AN) + ro + bj * HALF) = pack8(h0, h1);
                    if (PH == 3) { *(f32x4*)(out + ro + bj * HALF) = h0; *(f32x4*)(out + ro + bj * HALF + 4) = h1; }
                }
                if (PH < 2) { sq += __shfl_xor(sq, 16); sq += __shfl_xor(sq, 32); if (fq == 0) lpart[wc * 256 + rloc] = sq; }
            }
        if (PH < 2) {
            __syncthreads();
            if (tid < 256) (void)__hip_atomic_fetch_add((float*)(ws + WS_SS) + (size_t)PH * MT + u.pm * BM + tid, lpart[tid] + lpart[256 + tid] + lpart[512 + tid] + lpart[768 + tid], __ATOMIC_RELAXED, __HIP_MEMORY_SCOPE_AGENT);
        }
        __syncthreads();
    }
};
template <int PH> __device__ __forceinline__ NormP fused_normp(unsigned char* ws, float* out, const float* ng) {
    bf16_t* Fb = (bf16_t*)(ws + WS_F); bf16_t* HBb = (bf16_t*)out; bf16_t* ANb = (bf16_t*)(ws + WS_AN); float* FSb = (float*)(ws + WS_FS); float* RSb = (float*)(ws + WS_RS);
    if (PH == 0) return NormP{Fb, FSb, 11, HBb, HBb, nullptr, ng + 1 * D, 0.5f, RSb + 1 * MT, nullptr};
    if (PH == 1) return NormP{Fb, FSb, 4, HBb, HBb, nullptr, ng + 3 * D, 1.f, RSb + 2 * MT, nullptr};
    if (PH == 2) return NormP{Fb, FSb, 11, HBb, nullptr, nullptr, ng + 5 * D, 0.5f, nullptr, ANb};
    return NormP{Fb, FSb, 4, ANb, nullptr, out, ng + 6 * D, 1.f, nullptr, nullptr};
}
template <int OUTH, int ANM, bool PLE = false>
__device__ __forceinline__ void sample_norm(const Args& a, const NormP& p, unsigned* cnt, int nitems) {
    const int G = gridDim.x, lane = threadIdx.x & 63, wv = threadIdx.x >> 6;
    arrive_and_wait(cnt, (unsigned)nitems, (int)blockIdx.x < nitems, (int)blockIdx.x * 8 < MS);
    for (int r = MP + blockIdx.x * 8 + wv; r < MT; r += G * 8) {
        f32x4 h[4], f[4];
        norm_load_h<1>(a, p, r, lane, h);
#pragma unroll
        for (int i = 0; i < 4; ++i) { f32x4 v = *(const f32x4*)(p.FS + (size_t)(r - MP) * D + 256 * i + 4 * lane);
            for (int k = 1; k < p.nsplit; ++k) v = v + *(const f32x4*)(p.FS + ((size_t)k * MS + (r - MP)) * D + 256 * i + 4 * lane);
            if (PLE) { const u32x2 w = *(const u32x2*)(p.F + (size_t)r * D + 256 * i + 4 * lane);
                v[0] = sigmoidf_(v[0]) * bf_lo(w.x); v[1] = sigmoidf_(v[1]) * bf_hi(w.x); v[2] = sigmoidf_(v[2]) * bf_lo(w.y); v[3] = sigmoidf_(v[3]) * bf_hi(w.y); }
            f[i] = v; }
        norm_finish<true, OUTH, ANM>(p, r, lane, h, f);
    }
}

__device__ __forceinline__ float max3f(float a, float b, float c) { float r; asm("v_max3_f32 %0, %1, %2, %3" : "=v"(r) : "v"(a), "v"(b), "v"(c)); return r; }
constexpr float LOG2E = 1.4426950408889634f;
constexpr int AT_KS = 0, AT_VS = 9216, AT_BUF = 18432, AT_TB = 2 * 18432, AT_ROW = 144;
__device__ __forceinline__ int crow(int r, int hi) { return (r & 3) + 8 * (r >> 2) + 4 * hi; }

__device__ __forceinline__ void attn_unit(LAS unsigned char* lds, const bf16_t* qb, bf16_t* ob, const bf16_t* kbase, const bf16_t* vbase, int vpitch,
                                          const float* tb_g, int c0, int nq, bool samp) {
    const int tid = threadIdx.x, lane = tid & 63, w = __builtin_amdgcn_readfirstlane(tid >> 6), l32 = lane & 31, hi = lane >> 5;
    const int cw = c0 + (w >> 1), half = w & 1;
    const bool wact = (w >> 1) < nq && (!samp || w == 0);
    LAS float* tb = (LAS float*)(lds + AT_TB);
    __syncthreads();
    if (tid < 255) { const int d = tid - 63; tb[tid] = (tb_g[(d > 128 ? 128 : d) + 128] - tb_g[256]) * LOG2E; }
    bf16x8 qf[4];
    {
        int qr = (w >> 1) * 64 + half * 32 + l32; if (samp) qr &= 15; if (!wact) qr = 0;
        const bf16_t* qp = qb + (size_t)qr * 512 + 8 * hi;
#pragma unroll
        for (int ks = 0; ks < 4; ++ks) qf[ks] = *(const bf16x8*)(qp + 16 * ks);
    }
    f32x16 o0, o1;
#pragma unroll
    for (int i = 0; i < 16; ++i) { o0[i] = 0.f; o1[i] = 0.f; }
    float mrun = -1e30f, lrun = 0.f;
    const int kc_lo = c0 - 8 < 0 ? 0 : c0 - 8, kc_hi = c0 + nq - 1;
    const int rr = tid >> 3, seg = tid & 7;
    const bf16_t* kg = kbase + (size_t)rr * 512 + seg * 8;
    const bf16_t* vg = vbase + (size_t)rr * vpitch + seg * 8;
    u32x4 kv = *(const u32x4*)(kg + (size_t)(kc_lo * 64) * 512), vv = *(const u32x4*)(vg + kc_lo * 64);
    int buf = 0;
    for (int kc = kc_lo; kc <= kc_hi; ++kc) {
        LAS unsigned char* lb = lds + buf * AT_BUF;
        *(LAS u32x4*)(lb + AT_KS + rr * AT_ROW + seg * 16) = kv;
        *(LAS u32x4*)(lb + AT_VS + rr * AT_ROW + seg * 16) = vv;
        __syncthreads();
        if (kc < kc_hi) { kv = *(const u32x4*)(kg + (size_t)((kc + 1) * 64) * 512); vv = *(const u32x4*)(vg + (kc + 1) * 64); }
        buf ^= 1;
        if (wact && kc >= cw - 8 && kc <= cw) {
            f32x16 s0, s1;
            if (cw - kc >= 3) {
#pragma unroll
                for (int i = 0; i < 16; ++i) { s0[i] = 0.f; s1[i] = 0.f; }
            } else {
                const LAS float* ep = tb + ((cw - kc) * 64 + half * 32 + l32 - 4 * hi + 4);
#pragma unroll
                for (int i = 0; i < 16; ++i) { s0[i] = ep[59 - ((i & 3) + 8 * (i >> 2))]; s1[i] = ep[27 - ((i & 3) + 8 * (i >> 2))]; }
            }
#pragma unroll
            for (int ks = 0; ks < 4; ++ks) {
                const bf16x8 ka = *(const LAS bf16x8*)(lb + AT_KS + l32 * AT_ROW + ks * 32 + hi * 16);
                const bf16x8 kb = *(const LAS bf16x8*)(lb + AT_KS + (32 + l32) * AT_ROW + ks * 32 + hi * 16);
                s0 = __builtin_amdgcn_mfma_f32_32x32x16_bf16(ka, qf[ks], s0, 0, 0, 0);
                s1 = __builtin_amdgcn_mfma_f32_32x32x16_bf16(kb, qf[ks], s1, 0, 0, 0);
            }
            if (samp && kc == 8) {
#pragma unroll
                for (int i = 0; i < 16; ++i) { if (i >= 8) s0[i] = -1e30f; s1[i] = -1e30f; } }
            float mx = max3f(s0[0], s0[1], s1[0]);
            mx = max3f(mx, s1[1], s0[2]);
#pragma unroll
            for (int i = 3; i < 16; i += 2) { mx = max3f(mx, s0[i], s0[i < 15 ? i + 1 : i]); }
#pragma unroll
            for (int i = 2; i < 16; i += 2) { mx = max3f(mx, s1[i], s1[i + 1]); }
            mx = fmaxf(mx, __shfl_xor(mx, 32));
            const float mn = fmaxf(mrun, mx);
            if (__builtin_amdgcn_ballot_w64(mn > mrun) != 0) {
                const float alpha = __builtin_amdgcn_exp2f(mrun - mn);
                lrun *= alpha; mrun = mn;
#pragma unroll
                for (int i = 0; i < 16; ++i) { o0[i] *= alpha; o1[i] *= alpha; }
            }
            float rs = 0.f;
#pragma unroll
            for (int i = 0; i < 16; ++i) { s0[i] = __builtin_amdgcn_exp2f(s0[i] - mn); s1[i] = __builtin_amdgcn_exp2f(s1[i] - mn); rs += s0[i] + s1[i]; }
            rs += __shfl_xor(rs, 32);
            lrun += rs;
            bf16x8 pf[4];
#pragma unroll
            for (int kb2 = 0; kb2 < 2; ++kb2) {
                u32x4 a, b;
                a.x = cvt_pk_bf16(s0[8 * kb2 + 0], s0[8 * kb2 + 1]); a.y = cvt_pk_bf16(s0[8 * kb2 + 2], s0[8 * kb2 + 3]); a.z = cvt_pk_bf16(s0[8 * kb2 + 4], s0[8 * kb2 + 5]); a.w = cvt_pk_bf16(s0[8 * kb2 + 6], s0[8 * kb2 + 7]);
                b.x = cvt_pk_bf16(s1[8 * kb2 + 0], s1[8 * kb2 + 1]); b.y = cvt_pk_bf16(s1[8 * kb2 + 2], s1[8 * kb2 + 3]); b.z = cvt_pk_bf16(s1[8 * kb2 + 4], s1[8 * kb2 + 5]); b.w = cvt_pk_bf16(s1[8 * kb2 + 6], s1[8 * kb2 + 7]);
                pf[kb2] = __builtin_bit_cast(bf16x8, a); pf[2 + kb2] = __builtin_bit_cast(bf16x8, b);
            }
#pragma unroll
            for (int kt = 0; kt < 4; ++kt) {
                const s16x4 a0 = *(const LAS s16x4*)(lb + AT_VS + l32 * AT_ROW + (16 * kt + 4 * hi) * 2), a1 = *(const LAS s16x4*)(lb + AT_VS + l32 * AT_ROW + (16 * kt + 4 * hi) * 2 + 16);
                const s16x4 b0 = *(const LAS s16x4*)(lb + AT_VS + (32 + l32) * AT_ROW + (16 * kt + 4 * hi) * 2), b1 = *(const LAS s16x4*)(lb + AT_VS + (32 + l32) * AT_ROW + (16 * kt + 4 * hi) * 2 + 16);
                const bf16x8 va = (bf16x8){a0[0], a0[1], a0[2], a0[3], a1[0], a1[1], a1[2], a1[3]}, vb = (bf16x8){b0[0], b0[1], b0[2], b0[3], b1[0], b1[1], b1[2], b1[3]};
                o0 = __builtin_amdgcn_mfma_f32_32x32x16_bf16(va, pf[kt], o0, 0, 0, 0);
                o1 = __builtin_amdgcn_mfma_f32_32x32x16_bf16(vb, pf[kt], o1, 0, 0, 0);
            }
        }
    }
    if (wact) {
        const int qr = (w >> 1) * 64 + half * 32 + l32;
        if (!samp || qr < 16) {
            const float inv = 1.f / lrun;
            bf16_t* op = ob + (size_t)qr * 512 + 4 * hi;
#pragma unroll
            for (int g = 0; g < 4; ++g) {
                u32x2 x, y;
                x.x = cvt_pk_bf16(o0[4 * g] * inv, o0[4 * g + 1] * inv); x.y = cvt_pk_bf16(o0[4 * g + 2] * inv, o0[4 * g + 3] * inv);
                y.x = cvt_pk_bf16(o1[4 * g] * inv, o1[4 * g + 1] * inv); y.y = cvt_pk_bf16(o1[4 * g + 2] * inv, o1[4 * g + 3] * inv);
                *(u32x2*)(op + 8 * g) = x; *(u32x2*)(op + 32 + 8 * g) = y;
            }
        }
    }
}

#define XB_TMO      128
#define XB_XCNT(j)  (256  + 64 * (j))
#define XB_XSUB(j)  (1280 + 64 * (j))
#define XB_XGEN(j)  (2304 + 64 * (j))
#define XB_TOP      3328
#define XB_TOPGEN   3392
#define XCD_BAR_WORDS 3456
#define XB_SPIN_CAP (1u << 22)
__device__ __forceinline__ unsigned xb_ld(unsigned* p)              { return __hip_atomic_load(p, __ATOMIC_RELAXED, __HIP_MEMORY_SCOPE_AGENT); }
__device__ __forceinline__ unsigned xb_add(unsigned* p, unsigned v) { return __hip_atomic_fetch_add(p, v, __ATOMIC_RELAXED, __HIP_MEMORY_SCOPE_AGENT); }
__device__ __forceinline__ unsigned xb_xcc_id() { return (unsigned)__builtin_amdgcn_s_getreg((3 << 11) | 20) & 0xFu; }
#define XB_SPIN(cond, bar) do { unsigned _sp = 0; while (cond) { __builtin_amdgcn_s_sleep(1); \
    if ((++_sp & 255u) == 0u) { if (xb_ld(&(bar)[XB_TMO])) break; if (_sp > XB_SPIN_CAP) { atomicAdd(&(bar)[XB_TMO], 1u); break; } } } } while (0)
struct XcdBarrier { unsigned* bar; unsigned x; volatile LAS unsigned* st; };
__device__ __forceinline__ XcdBarrier xcd_barrier_post(unsigned* bar, volatile LAS unsigned* st) {
    XcdBarrier b; b.bar = bar; b.x = xb_xcc_id(); b.st = st;
    if (threadIdx.x == 0) (void)xb_add(&bar[XB_XCNT(b.x)], 1u);
    return b;
}
__device__ __forceinline__ void xcd_barrier_complete(unsigned* bar, unsigned x, unsigned& nloc, unsigned& nx) {
    const unsigned G = gridDim.x * gridDim.y * gridDim.z;
    unsigned sum, cnt, mine, sp = 0u;
    for (;;) {
        sum = 0u; cnt = 0u; mine = 0u;
#pragma unroll
        for (unsigned j = 0; j < 16; ++j) { const unsigned c = xb_ld(&bar[XB_XCNT(j)]); sum += c; cnt += (c > 0u) ? 1u : 0u; mine = (j == x) ? c : mine; }
        if (sum == G) break;
        __builtin_amdgcn_s_sleep(1);
        if ((++sp & 255u) == 0u) { if (xb_ld(&bar[XB_TMO])) break; if (sp > XB_SPIN_CAP) { atomicAdd(&bar[XB_TMO], 1u); break; } }
    }
    nloc = mine > 0u ? mine : 1u; nx = cnt > 0u ? cnt : 1u;
}
__device__ __forceinline__ void xcd_barrier(const XcdBarrier& b) {
    asm volatile("s_waitcnt vmcnt(0)" ::: "memory");
    __syncthreads();
    if (threadIdx.x == 0) {
        unsigned* bar = b.bar;
        __builtin_amdgcn_s_waitcnt(0);
        unsigned nloc = b.st[0], nx = b.st[1];
        if (nloc == 0u) { xcd_barrier_complete(bar, b.x, nloc, nx); b.st[0] = nloc; b.st[1] = nx; }
        const unsigned old = xb_add(&bar[XB_XSUB(b.x)], 1u);
        const unsigned gen = old / nloc;
        if (old + 1u == (gen + 1u) * nloc) {
            __builtin_amdgcn_fence(__ATOMIC_RELEASE, "agent");
            asm volatile("s_waitcnt vmcnt(0)" ::: "memory");
            const unsigned og = xb_add(&bar[XB_TOP], 1u);
            const unsigned tg = og / nx;
            if (og + 1u == (tg + 1u) * nx) xb_add(&bar[XB_TOPGEN], 1u);
            else XB_SPIN(xb_ld(&bar[XB_TOPGEN]) == tg, bar);
            __builtin_amdgcn_fence(__ATOMIC_ACQUIRE, "agent");
            xb_add(&bar[XB_XGEN(b.x)], 1u);
            asm volatile("s_waitcnt vmcnt(0)" ::: "memory");
        } else {
            XB_SPIN(xb_ld(&bar[XB_XGEN(b.x)]) == gen, bar);
            __builtin_amdgcn_fence(__ATOMIC_ACQUIRE, "agent");
            asm volatile("s_waitcnt vmcnt(0)" ::: "memory");
        }
    }
    __syncthreads();
}

__global__ void __launch_bounds__(512, 2) fwd_kernel(Args a) {
    extern __shared__ __attribute__((aligned(16))) unsigned char lds_raw[];
    LAS unsigned char* lds = (LAS unsigned char*)lds_raw;
    cg::grid_group grid = cg::this_grid();
    const int lo = a.ph_lo, hi = a.ph_hi, G = gridDim.x, tid = threadIdx.x;
    volatile LAS unsigned* bst = (volatile LAS unsigned*)(lds + 131072 + 1008);
    if (tid == 0) { bst[0] = 0u; bst[1] = 0u; }
    __syncthreads();
    XcdBarrier xbar = xcd_barrier_post((unsigned*)(a.ws + WS_CTL), bst);
    unsigned char* ws = a.ws;
    bf16_t* W1GU = (bf16_t*)(ws + WS_W1GU); bf16_t* W1D = (bf16_t*)(ws + WS_W1D); bf16_t* WIN = (bf16_t*)(ws + WS_WIN); bf16_t* WAO = (bf16_t*)(ws + WS_WAO);
    bf16_t* WCO = (bf16_t*)(ws + WS_WCO); bf16_t* WOUT = (bf16_t*)(ws + WS_WOUT); bf16_t* W2GU = (bf16_t*)(ws + WS_W2GU); bf16_t* W2D = (bf16_t*)(ws + WS_W2D);
    bf16_t* WPG = (bf16_t*)(ws + WS_WPG); bf16_t* WPP = (bf16_t*)(ws + WS_WPP); bf16_t* PB = (bf16_t*)(ws + WS_PB); bf16_t* AN = (bf16_t*)(ws + WS_AN);
    bf16_t* F = (bf16_t*)(ws + WS_F); bf16_t* ACT = (bf16_t*)(ws + WS_ACT); bf16_t* Qb = (bf16_t*)(ws + WS_Q); bf16_t* Kb = (bf16_t*)(ws + WS_K);
    bf16_t* Vt = (bf16_t*)(ws + WS_VT); bf16_t* Vts = (bf16_t*)(ws + WS_VTS); bf16_t* Sb = (bf16_t*)(ws + WS_S); bf16_t* Bg = (bf16_t*)(ws + WS_BG);
    bf16_t* SA = (bf16_t*)(ws + WS_SA); bf16_t* SC = (bf16_t*)(ws + WS_SC); bf16_t* MM = (bf16_t*)(ws + WS_MM); bf16_t* ATT = (bf16_t*)(ws + WS_ATT); bf16_t* YC = (bf16_t*)(ws + WS_YC);
    float* H = a.out + O_Y;
    float* FSP = (float*)(ws + WS_FS);
    float* RS = (float*)(ws + WS_RS);
    unsigned* CW = (unsigned*)(ws + WS_CTL);
    bf16_t* HB = (bf16_t*)(a.out + O_Y);
    const float* ng = a.in[I_NG];
#define IN(k) (lo <= (k) && (k) < hi)
#define SEAM(k) do { if (IN(k) && IN((k) + 1)) xcd_barrier(xbar); } while (0)
    if (lo < 0) grid.sync();

    auto ident = [](int cb, int& c0, int& r0) { c0 = 64 * cb; r0 = 64 * cb; };
    auto gate = [](int cb, int& c0, int& r0) { c0 = 64 * cb; r0 = 256 * (cb >> 1) + 64 * (cb & 1); };
    auto up = [](int cb, int& c0, int& r0) { c0 = 64 * cb; r0 = 256 * (cb >> 1) + 128 + 64 * (cb & 1); };
    auto winmap = [](int db, int& c0, int& r0) { r0 = 64 * db; const int pn = db >> 2, q = db & 3;
        if (pn < 6) c0 = 256 * pn + 64 * q; else if (pn < 10) c0 = (q < 2 ? 1536 : 2560) + 128 * (pn - 6) + 64 * (q & 1); else if (pn < 12) c0 = 2048 + 256 * (pn - 10) + 64 * q; else c0 = 3072 + 256 * (pn - 12) + 64 * q; };
    if (IN(0)) {
        LAS float* t = (LAS float*)lds;
        int job = 0;
        tr_matrix(t, job, G, (int)blockIdx.x, a.in[I_W1G], FF, D, FF / 64, W1GU, D, gate, ng + 0 * D);
        tr_matrix(t, job, G, (int)blockIdx.x, a.in[I_W1U], FF, D, FF / 64, W1GU, D, up, ng + 0 * D);
        norm_rows<0, false, 1, 1>(a, NormP{nullptr, nullptr, 0, nullptr, HB, nullptr, nullptr, 0.f, RS + 0 * MT, nullptr});
    }
    SEAM(0);
    if (IN(1)) { pg8::Gemm g{HB, W1GU, D, D}; pg8::StaticOrder S; S.init(MT, 2 * FF, G, blockIdx.x); pg8::EpiGateUp E{ACT, RS + 0 * MT, nullptr}; pg8::gemm_phase(lds, g, S, E);
        constexpr int NB = (MT / 256) * (2 * FF / 256) % 256;
        const int me = (int)blockIdx.x - NB, nw = G - NB;
        if (me >= 0) { LAS float* t = (LAS float*)lds; int job = 0;
            tr_matrix(t, job, nw, me, a.in[I_W1D], D, FF, D / 64, W1D, FF, ident);
            tr_matrix(t, job, nw, me, a.in[I_WIN], DIN, D, DIN / 64, WIN, D, winmap, ng + 2 * D);
            tr_matrix(t, job, nw, me, a.in[I_WAO], D, DA, D / 64, WAO, DA, ident);
            tr_matrix(t, job, nw, me, a.in[I_WCO], D, DA, D / 64, WCO, DA, ident);
            tr_matrix(t, job, nw, me, a.in[I_WOUT], D, D, D / 64, WOUT, D, ident);
            for (size_t i = (size_t)me * 512 + threadIdx.x; i < (size_t)MT * DPLE / 16; i += (size_t)nw * 512) {
                const size_t e = i * 8; const float* src = e < (size_t)MP * DPLE ? a.in[I_PP] + e : a.in[I_PS] + (e - (size_t)MP * DPLE);
                *(u32x4*)(PB + e) = pg8::pack8(*(const f32x4*)src, *(const f32x4*)(src + 4)); } } }
    SEAM(1);
    if (IN(2)) {
        { pg8::Gemm g{ACT, W1D, FF, FF}; pg8::StaticOrder S; S.init(MP, D, G, blockIdx.x);
          EpiX<0> E{ws, a.out, ng, lds}; pg8::gemm_phase(lds, g, S, E); }
        { const int id = blockIdx.x, ks = id % 11, t = id / 11;
          pg8::Gemm g2{ACT + ks * (FF / 11), W1D + ks * (FF / 11), FF / 11, FF}; pg8::OneUnit S2{MP / 256 + (t >> 2), t & 3, id < 8 * 11}; pg8::EpiPartial E2{FSP + (size_t)ks * MS * D}; pg8::gemm_phase(lds, g2, S2, E2); }
        sample_norm<1, 1>(a, fused_normp<0>(ws, a.out, ng), CW + CW_SAMPLE + 0, 8 * 11);
    }
    SEAM(2);
    if (IN(4)) { pg8::Gemm g{HB, WIN, D, D}; pg8::StaticOrder S; S.init(MT, DIN, G, blockIdx.x); pg8::EpiWin E{Qb, Kb, Vt, Vts, Sb, Bg, SA, SC, a.out, RS + 1 * MT, (const float*)(ws + WS_SS) + 0 * MT}; pg8::gemm_phase(lds, g, S, E);
        constexpr int NB = (MT / 256) * (DIN / 256) % 256;
        const int me = (int)blockIdx.x - NB, nw = G - NB;
        if (me >= 0) {
            LAS float* t = (LAS float*)lds; int job = 0;
            for (int b = 0; b < SB; ++b)
                tr_matrix(t, job, nw, me, a.in[I_CV] + (size_t)b * 512 * 512, 512, 512, 8, Vts + (size_t)b * 512 * SKV, SKV, ident);
            for (size_t i = (size_t)me * 512 + threadIdx.x; i < (size_t)SB * 512 * 512 / 8; i += (size_t)nw * 512) {
                const size_t e = i * 8; const int b = (int)(e >> 18), rem = (int)(e & 262143);
                const float* src = a.in[I_CK] + e;
                *(u32x4*)(Kb + ((size_t)MP + (size_t)b * SKV) * 512 + rem) = pg8::pack8(*(const f32x4*)src, *(const f32x4*)(src + 4));
            } } }
    SEAM(4);
    if (IN(5)) {
        const float* rb = a.in[I_RB];
        for (int u = blockIdx.x; u < NB * 8 * 32 + SB * 8; u += G) {
            if (u < NB * 8 * 32) { const int j = u & 31, h = (u >> 5) & 7, b = u >> 8;
                attn_unit(lds, Qb + ((size_t)b * SEQ + j * 256) * 512 + h * 64, ATT + ((size_t)b * SEQ + j * 256) * 512 + h * 64, Kb + (size_t)b * SEQ * 512 + h * 64,
                          Vt + ((size_t)b * 512 + h * 64) * SEQ, SEQ, rb + h * 257, 4 * j, 4, false);
            } else { const int us = u - NB * 8 * 32, h = us & 7, b = us >> 3;
                attn_unit(lds, Qb + ((size_t)MP + b * ST) * 512 + h * 64, ATT + ((size_t)MP + b * ST) * 512 + h * 64, Kb + ((size_t)MP + (size_t)b * SKV) * 512 + h * 64,
                          Vts + ((size_t)b * 512 + h * 64) * SKV, SKV, rb + h * 257, 8, 1, true);
            }
        }
        const float* cw = a.in[I_CW]; const float* cc = a.in[I_CC];
        for (size_t i = (size_t)blockIdx.x * 512 + tid; i < (size_t)(MT / 4) * 64; i += (size_t)G * 512) {
            const int r0 = (int)(i >> 6) * 4, c = (int)(i & 63) * 8;
            int t0; const float* pre = nullptr;
            if (r0 < MP) t0 = r0 & 8191; else { const int rs = r0 - MP; t0 = rs & 15; pre = cc + (size_t)(rs >> 4) * 2 * 512; }
            f32x4 sa[6], sb[6], ba[4], bb[4];
#pragma unroll
            for (int k = 0; k < 4; ++k) { pg8::unpack8(*(const u32x4*)(Sb + (size_t)(r0 + k) * 512 + c), sa[k + 2], sb[k + 2]); pg8::unpack8(*(const u32x4*)(Bg + (size_t)(r0 + k) * 512 + c), ba[k], bb[k]); }
            if (t0 != 0) { pg8::unpack8(*(const u32x4*)(Sb + (size_t)(r0 - 2) * 512 + c), sa[0], sb[0]); pg8::unpack8(*(const u32x4*)(Sb + (size_t)(r0 - 1) * 512 + c), sa[1], sb[1]); }
            else if (pre) { sa[0] = *(const f32x4*)(pre + c); sb[0] = *(const f32x4*)(pre + c + 4); sa[1] = *(const f32x4*)(pre + 512 + c); sb[1] = *(const f32x4*)(pre + 512 + c + 4); }
            else { sa[0] = (f32x4){0.f, 0.f, 0.f, 0.f}; sb[0] = sa[0]; sa[1] = sa[0]; sb[1] = sa[0]; }
            const f32x4 w0a = *(const f32x4*)(cw + c), w0b = *(const f32x4*)(cw + c + 4), w1a = *(const f32x4*)(cw + 512 + c), w1b = *(const f32x4*)(cw + 512 + c + 4),
                        w2a = *(const f32x4*)(cw + 1024 + c), w2b = *(const f32x4*)(cw + 1024 + c + 4);
#pragma unroll
            for (int k = 0; k < 4; ++k) {
                const f32x4 ya = ba[k] * (sa[k] * w0a + sa[k + 1] * w1a + sa[k + 2] * w2a), yb = bb[k] * (sb[k] * w0b + sb[k + 1] * w1b + sb[k + 2] * w2b);
                *(u32x4*)(YC + (size_t)(r0 + k) * 512 + c) = pg8::pack8(ya, yb);
            }
        }
    }
    SEAM(5);
    if (IN(6)) {
        constexpr int NB6 = (MT / 256) * (D / 256) % 256;
        const int me6 = (int)blockIdx.x - NB6, nw6 = G - NB6;
        { pg8::Gemm g{ATT, WAO, DA, DA}; pg8::StaticOrder S; S.init(MT, D, G, blockIdx.x); pg8::EpiStd<1> E{MM, SA, D}; pg8::gemm_phase(lds, g, S, E); }
        if (me6 >= 0) { LAS float* t = (LAS float*)lds; int job = 0;
            tr_matrix(t, job, nw6, me6, a.in[I_W2G], FF, D, FF / 64, W2GU, D, gate, ng + 4 * D);
            tr_matrix(t, job, nw6, me6, a.in[I_W2U], FF, D, FF / 64, W2GU, D, up, ng + 4 * D); }
        { pg8::Gemm g{YC, WCO, DA, DA}; pg8::StaticOrder S; S.init(MT, D, G, blockIdx.x); pg8::EpiStd<2> E{MM, SC, D}; pg8::gemm_phase(lds, g, S, E); }
        if (me6 >= 0) { LAS float* t = (LAS float*)lds; int job = 0; tr_matrix(t, job, nw6, me6, a.in[I_W2D], D, FF, D / 64, W2D, FF, ident); }
    }
    SEAM(6);
    if (IN(7)) {
        { pg8::Gemm g{MM, WOUT, D, D}; pg8::StaticOrder S; S.init(MP, D, G, blockIdx.x);
          EpiX<1> E{ws, a.out, ng, lds}; pg8::gemm_phase(lds, g, S, E); }
        { const int id = blockIdx.x, ks = id % 4, t = id / 4;
          pg8::Gemm g2{MM + ks * (D / 4), WOUT + ks * (D / 4), D / 4, D}; pg8::OneUnit S2{MP / 256 + (t >> 2), t & 3, id < 8 * 4}; pg8::EpiPartial E2{FSP + (size_t)ks * MS * D}; pg8::gemm_phase(lds, g2, S2, E2); }
        sample_norm<1, 1>(a, fused_normp<1>(ws, a.out, ng), CW + CW_SAMPLE + 1, 8 * 4);
    }
    SEAM(7);
    if (IN(9)) { pg8::Gemm g{HB, W2GU, D, D}; pg8::StaticOrder S; S.init(MT, 2 * FF, G, blockIdx.x); pg8::EpiGateUp E{ACT, RS + 2 * MT, (const float*)(ws + WS_SS) + 1 * MT}; pg8::gemm_phase(lds, g, S, E);
        constexpr int NB = (MT / 256) * (2 * FF / 256) % 256;
        const int me = (int)blockIdx.x - NB, nw = G - NB;
        if (me >= 0) { LAS float* t = (LAS float*)lds; int job = 0;
            tr_matrix(t, job, nw, me, a.in[I_WPG], D, D, D / 64, WPG, D, ident);
            tr_matrix(t, job, nw, me, a.in[I_WPP], D, DPLE, D / 64, WPP, DPLE, ident);
            for (size_t i = (size_t)MT * DPLE / 16 + (size_t)me * 512 + threadIdx.x; i < (size_t)MT * DPLE / 8; i += (size_t)nw * 512) {
                const size_t e = i * 8; const float* src = e < (size_t)MP * DPLE ? a.in[I_PP] + e : a.in[I_PS] + (e - (size_t)MP * DPLE);
                *(u32x4*)(PB + e) = pg8::pack8(*(const f32x4*)src, *(const f32x4*)(src + 4));
            } } }
    SEAM(9);
    if (IN(10)) {
        { pg8::Gemm g{ACT, W2D, FF, FF}; pg8::StaticOrder S; S.init(MP, D, G, blockIdx.x);
          EpiX<2> E{ws, a.out, ng, lds}; pg8::gemm_phase(lds, g, S, E); }
        { const int id = blockIdx.x, ks = id % 11, t = id / 11;
          pg8::Gemm g2{ACT + ks * (FF / 11), W2D + ks * (FF / 11), FF / 11, FF}; pg8::OneUnit S2{MP / 256 + (t >> 2), t & 3, id < 8 * 11}; pg8::EpiPartial E2{FSP + (size_t)ks * MS * D}; pg8::gemm_phase(lds, g2, S2, E2); }
        sample_norm<0, 2>(a, fused_normp<2>(ws, a.out, ng), CW + CW_SAMPLE + 2, 8 * 11);
    }
    SEAM(10);
    if (IN(12)) {
        const int id = blockIdx.x;
        { pg8::Gemm g{PB, WPP, DPLE, DPLE}; pg8::StaticOrder S; S.init(MP, D, G, blockIdx.x); pg8::EpiStd<0> E{F, nullptr, D}; pg8::gemm_phase(lds, g, S, E);
          pg8::OneUnit S2{MP / 256 + (id >> 2), id & 3, id < 8}; pg8::gemm_phase(lds, g, S2, E); }
        { pg8::Gemm g{AN, WPG, D, D}; pg8::StaticOrder S; S.init(MP, D, G, blockIdx.x);
          EpiX<3> E{ws, a.out, ng, lds}; pg8::gemm_phase(lds, g, S, E); }
        { const int ks = id % 4, t = id / 4;
          pg8::Gemm g2{AN + ks * (D / 4), WPG + ks * (D / 4), D / 4, D}; pg8::OneUnit S2{MP / 256 + (t >> 2), t & 3, id < 8 * 4}; pg8::EpiPartial E2{FSP + (size_t)ks * MS * D}; pg8::gemm_phase(lds, g2, S2, E2); }
        sample_norm<2, 0, true>(a, fused_normp<3>(ws, a.out, ng), CW + CW_SAMPLE + 3, 8 * 4);
    }
#undef IN
#undef SEAM
}

constexpr int N_PHASES = 14;
#ifndef ONE_LAUNCH
#define ONE_LAUNCH 1
#endif
extern "C" void kernel_launch(void* const* d_in, const int* in_sizes, int n_in, void* d_out, int out_size, void* d_ws, size_t ws_size, hipStream_t stream) {
    static int grid = 0;
    if (grid == 0) {
        if (n_in != 22 || (size_t)out_size != O_END || ws_size < WS_TOTAL) { fprintf(stderr, "kernel_launch: unexpected shapes (n_in %d out %d ws %zu need %zu)\n", n_in, out_size, ws_size, (size_t)WS_END); grid = -1; return; }
        int dev = 0, cus = 0, per_cu = 0;
        (void)hipGetDevice(&dev); (void)hipDeviceGetAttribute(&cus, hipDeviceAttributeMultiprocessorCount, dev);
        if (hipFuncSetAttribute((const void*)fwd_kernel, hipFuncAttributeMaxDynamicSharedMemorySize, LDS_BYTES) != hipSuccess) { fprintf(stderr, "kernel_launch: hipFuncSetAttribute failed\n"); grid = -1; return; }
        if (hipOccupancyMaxActiveBlocksPerMultiprocessor(&per_cu, (const void*)fwd_kernel, 512, LDS_BYTES) != hipSuccess || per_cu < 1) { fprintf(stderr, "kernel_launch: occupancy query gave %d\n", per_cu); per_cu = 1; }
        (void)hipGetLastError();
        grid = cus * per_cu;
    }
    if (grid < 0) return;
    Args a{};
    for (int i = 0; i < 22; ++i) a.in[i] = (const float*)d_in[i];
    a.out = (float*)d_out; a.ws = (unsigned char*)d_ws;
#if ONE_LAUNCH
    if (hipMemsetAsync((char*)d_ws + WS_CTL, 0, CTL_BYTES, stream) != hipSuccess) { fprintf(stderr, "kernel_launch: memset of the barrier words failed\n"); return; }
    a.ph_lo = 0; a.ph_hi = N_PHASES;
    void* args[] = {&a};
    hipError_t e = hipLaunchCooperativeKernel((const void*)fwd_kernel, dim3(grid), dim3(512), args, LDS_BYTES, stream);
    if (e != hipSuccess) fprintf(stderr, "cooperative launch failed: %s (grid %d)\n", hipGetErrorString(e), grid);
#else
    for (int p = 0; p < N_PHASES; ++p) { a.ph_lo = p; a.ph_hi = p + 1; hipLaunchKernelGGL(fwd_kernel, dim3(grid), dim3(512), LDS_BYTES, stream, a); }
#endif
}
```
